# Optimizing an MI355X kernel written in HIP

```python
import math
import jax, jax.numpy as jnp
from jax import lax
import numpy as np

D_MODEL = 1024
BATCH = 16
SEQ = 2048
DEPTH = 2
DEC_BATCH = 32
DEC_SEQ = 64
PAST_LEN = 2048

CHUNK = 64
N_A = DEPTH // 2
N_B = DEPTH - N_A
EPS = 1e-6

SSM_EXPAND = 2
D_INNER = SSM_EXPAND * D_MODEL
SSM_HEADDIM = 64
SSM_HEADS = D_INNER // SSM_HEADDIM
SSM_GROUPS = 4
SSM_HPG = SSM_HEADS // SSM_GROUPS
D_STATE = 128
SSM_CONV = 4
CONV_DIM = D_INNER + 2 * SSM_GROUPS * D_STATE
IN_PROJ_DIM = D_INNER + CONV_DIM + SSM_HEADS

MLA_HEADS = 16
Q_RANK = 384
KV_RANK = 256
QK_NOPE = 128
QK_ROPE = 64
V_DIM = 128
ROPE_THETA = 10000.0
Q_BLOCK = 128

D_FF = 2816
FFN_CONV = 3

kernel_name = 'streaming_ssd_mla_yoco_step'

F32 = jnp.float32


def rmsnorm(x, g):
    xf = x.astype(F32)
    y = xf * lax.rsqrt(jnp.mean(xf * xf, axis=-1, keepdims=True) + EPS)
    return (y * g.astype(F32)).astype(x.dtype)


def causal_dwconv(u, buf, w, b):
    k = w.shape[0]
    t = u.shape[1]
    ext = jnp.concatenate([buf.astype(u.dtype), u], axis=1)
    out = ext[:, 0:t] * w[0]
    for i in range(1, k):
        out = out + ext[:, i:i + t] * w[i]
    return out + b, ext[:, t:]


def rope(x, pos):
    half = QK_ROPE // 2
    inv = jnp.exp(-math.log(ROPE_THETA) * jnp.arange(half, dtype=F32) / half)
    ang = pos.astype(F32)[:, None] * inv[None, :]
    shp = (pos.shape[0],) + (1,) * (x.ndim - 3) + (half,)
    cos = jnp.cos(ang).reshape(shp)
    sin = jnp.sin(ang).reshape(shp)
    xf = x.astype(F32)
    x1, x2 = xf[..., :half], xf[..., half:]
    return jnp.concatenate([x1 * cos - x2 * sin, x2 * cos + x1 * sin], axis=-1).astype(x.dtype)


def ssd_scan(x, dt, a, bmat, cmat, h0):
    bsz, t = x.shape[0], x.shape[1]
    l = min(CHUNK, t)
    nc = t // l
    xc = x.astype(F32).reshape(bsz, nc, l, SSM_GROUPS, SSM_HPG, SSM_HEADDIM)
    dtc = dt.astype(F32).reshape(bsz, nc, l, SSM_GROUPS, SSM_HPG)
    bc = bmat.astype(F32).reshape(bsz, nc, l, SSM_GROUPS, D_STATE)
    cc = cmat.astype(F32).reshape(bsz, nc, l, SSM_GROUPS, D_STATE)
    da = dtc * a.astype(F32).reshape(SSM_GROUPS, SSM_HPG)
    acs = jnp.cumsum(da, axis=2)
    seg = acs[:, :, :, None] - acs[:, :, None]
    causal = jnp.tril(jnp.ones((l, l), dtype=bool))[:, :, None, None]
    decay = jnp.exp(jnp.where(causal, seg, -jnp.inf))
    cb = jnp.einsum('bclgn,bcsgn->bclsg', cc, bc)
    wts = cb[..., None] * decay * dtc[:, :, None]
    y_diag = jnp.einsum('bclsge,bcsgep->bclgep', wts, xc)
    decay_end = jnp.exp(acs[:, :, -1:] - acs)
    states = jnp.einsum('bclgn,bclge,bclgep->bcgepn', bc, decay_end * dtc, xc)
    chunk_decay = jnp.exp(acs[:, :, -1])

    def step(h, inp):
        s_c, d_c = inp
        return h * d_c[..., None, None] + s_c, h

    h_init = h0.astype(F32).reshape(bsz, SSM_GROUPS, SSM_HPG, SSM_HEADDIM, D_STATE)
    h_last, h_prev = lax.scan(step, h_init, (jnp.moveaxis(states, 1, 0), jnp.moveaxis(chunk_decay, 1, 0)))
    h_prev = jnp.moveaxis(h_prev, 0, 1)
    y_off = jnp.einsum('bclgn,bcgepn,bclge->bclgep', cc, h_prev, jnp.exp(acs))
    y = (y_diag + y_off).reshape(bsz, t, SSM_HEADS, SSM_HEADDIM)
    return y.astype(x.dtype), h_last.reshape(bsz, SSM_HEADS, SSM_HEADDIM, D_STATE).astype(h0.dtype)


def mamba2_mixer(h, conv_buf, ssm_state, w_in, conv_w, conv_b, dt_bias, a_log, d_skip, g_norm, w_out):
    bsz, t, _ = h.shape
    zxbcdt = h @ w_in
    z, xbc, dt = jnp.split(zxbcdt, [D_INNER, D_INNER + CONV_DIM], axis=-1)
    xbc_c, new_buf = causal_dwconv(xbc, conv_buf, conv_w, conv_b)
    xbc_c = jax.nn.silu(xbc_c)
    xs, bm, cm = jnp.split(xbc_c, [D_INNER, D_INNER + SSM_GROUPS * D_STATE], axis=-1)
    xs = xs.reshape(bsz, t, SSM_HEADS, SSM_HEADDIM)
    bm = bm.reshape(bsz, t, SSM_GROUPS, D_STATE)
    cm = cm.reshape(bsz, t, SSM_GROUPS, D_STATE)
    dtp = jax.nn.softplus(dt.astype(F32) + dt_bias.astype(F32))
    a = -jnp.exp(a_log.astype(F32))
    y, new_state = ssd_scan(xs, dtp, a, bm, cm, ssm_state)
    y = y + xs * d_skip[:, None]
    yg = (y.reshape(bsz, t, D_INNER) * jax.nn.silu(z)).reshape(bsz, t, SSM_GROUPS, D_INNER // SSM_GROUPS)
    yg = rmsnorm(yg, g_norm.reshape(SSM_GROUPS, D_INNER // SSM_GROUPS)).reshape(bsz, t, D_INNER)
    return yg @ w_out, new_buf, new_state


def conv_ffn(h, buf, w_up, conv_w, conv_b, w_down):
    u = h @ w_up
    u, new_buf = causal_dwconv(u, buf, conv_w, conv_b)
    val, gate = jnp.split(u, 2, axis=-1)
    return (jax.nn.gelu(gate, approximate=True) * val) @ w_down, new_buf


def mla_shared_kv(x, pos, g_in, w_dkv, g_kv, w_kr):
    h = rmsnorm(x, g_in)
    c_kv = rmsnorm(h @ w_dkv, g_kv)
    k_pe = rope(h @ w_kr, pos)
    return c_kv, k_pe


def mla_attend(h, pos_q, c_kv, k_pe, pos_k, w_dq, g_q, w_uq, w_uk, w_uv, w_o):
    bsz, t, _ = h.shape
    c_q = rmsnorm(h @ w_dq, g_q)
    q = (c_q @ w_uq).reshape(bsz, t, MLA_HEADS, QK_NOPE + QK_ROPE)
    q_nope, q_pe = q[..., :QK_NOPE], q[..., QK_NOPE:]
    q_pe = rope(q_pe, pos_q)
    q_lat = jnp.einsum('bthd,rhd->bthr', q_nope, w_uk)
    scale = (QK_NOPE + QK_ROPE) ** -0.5
    blk = min(Q_BLOCK, t)
    nb = t // blk
    ql_b = q_lat.reshape(bsz, nb, blk, MLA_HEADS, KV_RANK).swapaxes(0, 1)
    qp_b = q_pe.reshape(bsz, nb, blk, MLA_HEADS, QK_ROPE).swapaxes(0, 1)
    pq_b = pos_q.reshape(nb, blk)
    k_chunk = pos_k // CHUNK

    def attend_block(args):
        ql, qp, pq = args
        s = jnp.einsum('bqhr,bkr->bhqk', ql, c_kv).astype(F32) + jnp.einsum('bqhd,bkd->bhqk', qp, k_pe).astype(F32)
        s = s * scale
        mask = (pq // CHUNK)[:, None] >= k_chunk[None, :]
        s = jnp.where(mask[None, None], s, -jnp.inf)
        p = jax.nn.softmax(s, axis=-1).astype(c_kv.dtype)
        return jnp.einsum('bhqk,bkr->bqhr', p, c_kv)

    o_lat = lax.map(attend_block, (ql_b, qp_b, pq_b))
    o_lat = o_lat.swapaxes(0, 1).reshape(bsz, t, MLA_HEADS, KV_RANK)
    o = jnp.einsum('bthr,rhv->bthv', o_lat, w_uv).reshape(bsz, t, MLA_HEADS * V_DIM)
    return o @ w_o


def trunk(x, ssm_conv_buf, ssm_state, ffn_buf, past_lat, past_kpe, weights):
    (norm_mix_pre, norm_mix_post, norm_ffn_pre, norm_ffn_post,
     ssm_w_in, ssm_conv_w, ssm_conv_b, ssm_dt_bias, ssm_a_log, ssm_d, ssm_norm, ssm_w_out,
     kv_norm_in, kv_w_dkv, kv_norm, kv_w_kr, kv_w_uk, kv_w_uv,
     mla_w_dq, mla_q_norm, mla_w_uq, mla_w_o,
     ffn_w_up, ffn_conv_w, ffn_conv_b, ffn_w_down) = weights
    t = x.shape[1]
    past = past_lat.shape[1]
    pos_q = past + jnp.arange(t, dtype=jnp.int32)
    pos_k = jnp.arange(past + t, dtype=jnp.int32)
    new_ssm_conv, new_ssm_state, new_ffn = [], [], []
    c_kv = k_pe = new_lat = new_kpe = None
    for layer in range(DEPTH):
        h = rmsnorm(x, norm_mix_pre[layer])
        if layer < N_A:
            mix, cbuf, st = mamba2_mixer(h, ssm_conv_buf[layer], ssm_state[layer], ssm_w_in[layer], ssm_conv_w[layer],
                                         ssm_conv_b[layer], ssm_dt_bias[layer], ssm_a_log[layer], ssm_d[layer],
                                         ssm_norm[layer], ssm_w_out[layer])
            new_ssm_conv.append(cbuf)
            new_ssm_state.append(st)
        else:
            j = layer - N_A
            mix = mla_attend(h, pos_q, c_kv, k_pe, pos_k, mla_w_dq[j], mla_q_norm[j], mla_w_uq[j], kv_w_uk, kv_w_uv, mla_w_o[j])
        x = x + rmsnorm(mix, norm_mix_post[layer])
        f, fbuf = conv_ffn(rmsnorm(x, norm_ffn_pre[layer]), ffn_buf[layer], ffn_w_up[layer], ffn_conv_w[layer],
                           ffn_conv_b[layer], ffn_w_down[layer])
        x = x + rmsnorm(f, norm_ffn_post[layer])
        new_ffn.append(fbuf)
        if layer == N_A - 1:
            new_lat, new_kpe = mla_shared_kv(x, pos_q, kv_norm_in, kv_w_dkv, kv_norm, kv_w_kr)
            c_kv = jnp.concatenate([past_lat.astype(new_lat.dtype), new_lat], axis=1)
            k_pe = jnp.concatenate([past_kpe.astype(new_kpe.dtype), new_kpe], axis=1)
    return (x, jnp.stack(new_ssm_state), jnp.stack(new_ssm_conv), jnp.stack(new_ffn), new_lat, new_kpe)


def setup_inputs(seed: int = 0) -> dict:
    key = jax.random.key(seed)
    ks = iter(jax.random.split(key, 48))

    def nrm(shape, scale):
        return jax.random.normal(next(ks), shape, F32) * scale

    def gain(shape):
        return 1.0 + nrm(shape, 0.02)

    dt0 = jnp.exp(jax.random.uniform(next(ks), (N_A, SSM_HEADS), F32, math.log(1e-3), math.log(1e-1)))
    return {
        'x_prompt': nrm((BATCH, SEQ, D_MODEL), 1.0),
        'x_sample': nrm((DEC_BATCH, DEC_SEQ, D_MODEL), 1.0),
        'state_ssm': nrm((N_A, DEC_BATCH, SSM_HEADS, SSM_HEADDIM, D_STATE), 0.1),
        'state_ssm_conv': nrm((N_A, DEC_BATCH, SSM_CONV - 1, CONV_DIM), 1.0),
        'state_ffn_conv': nrm((DEPTH, DEC_BATCH, FFN_CONV - 1, 2 * D_FF), 1.0),
        'cache_kv_latent': nrm((DEC_BATCH, PAST_LEN, KV_RANK), 1.0),
        'cache_k_rope': nrm((DEC_BATCH, PAST_LEN, QK_ROPE), 1.0),
        'norm_mix_pre': gain((DEPTH, D_MODEL)),
        'norm_mix_post': gain((DEPTH, D_MODEL)),
        'norm_ffn_pre': gain((DEPTH, D_MODEL)),
        'norm_ffn_post': gain((DEPTH, D_MODEL)),
        'ssm_w_in': nrm((N_A, D_MODEL, IN_PROJ_DIM), D_MODEL ** -0.5),
        'ssm_conv_w': nrm((N_A, SSM_CONV, CONV_DIM), SSM_CONV ** -0.5),
        'ssm_conv_b': nrm((N_A, CONV_DIM), 0.02),
        'ssm_dt_bias': dt0 + jnp.log(-jnp.expm1(-dt0)),
        'ssm_a_log': jnp.log(jax.random.uniform(next(ks), (N_A, SSM_HEADS), F32, 1.0, 16.0)),
        'ssm_d': gain((N_A, SSM_HEADS)),
        'ssm_norm': gain((N_A, D_INNER)),
        'ssm_w_out': nrm((N_A, D_INNER, D_MODEL), D_INNER ** -0.5),
        'kv_norm_in': gain((D_MODEL,)),
        'kv_w_dkv': nrm((D_MODEL, KV_RANK), D_MODEL ** -0.5),
        'kv_norm': gain((KV_RANK,)),
        'kv_w_kr': nrm((D_MODEL, QK_ROPE), D_MODEL ** -0.5),
        'kv_w_uk': nrm((KV_RANK, MLA_HEADS, QK_NOPE), QK_NOPE ** -0.5),
        'kv_w_uv': nrm((KV_RANK, MLA_HEADS, V_DIM), KV_RANK ** -0.5),
        'mla_w_dq': nrm((N_B, D_MODEL, Q_RANK), D_MODEL ** -0.5),
        'mla_q_norm': gain((N_B, Q_RANK)),
        'mla_w_uq': nrm((N_B, Q_RANK, MLA_HEADS * (QK_NOPE + QK_ROPE)), Q_RANK ** -0.5),
        'mla_w_o': nrm((N_B, MLA_HEADS * V_DIM, D_MODEL), (MLA_HEADS * V_DIM) ** -0.5),
        'ffn_w_up': nrm((DEPTH, D_MODEL, 2 * D_FF), D_MODEL ** -0.5),
        'ffn_conv_w': nrm((DEPTH, FFN_CONV, 2 * D_FF), FFN_CONV ** -0.5),
        'ffn_conv_b': nrm((DEPTH, 2 * D_FF), 0.02),
        'ffn_w_down': nrm((DEPTH, D_FF, D_MODEL), D_FF ** -0.5),
    }


def reference(x_prompt, x_sample, state_ssm, state_ssm_conv, state_ffn_conv, cache_kv_latent, cache_k_rope,
              norm_mix_pre, norm_mix_post, norm_ffn_pre, norm_ffn_post,
              ssm_w_in, ssm_conv_w, ssm_conv_b, ssm_dt_bias, ssm_a_log, ssm_d, ssm_norm, ssm_w_out,
              kv_norm_in, kv_w_dkv, kv_norm, kv_w_kr, kv_w_uk, kv_w_uv,
              mla_w_dq, mla_q_norm, mla_w_uq, mla_w_o,
              ffn_w_up, ffn_conv_w, ffn_conv_b, ffn_w_down):
    weights = (norm_mix_pre, norm_mix_post, norm_ffn_pre, norm_ffn_post,
               ssm_w_in, ssm_conv_w, ssm_conv_b, ssm_dt_bias, ssm_a_log, ssm_d, ssm_norm, ssm_w_out,
               kv_norm_in, kv_w_dkv, kv_norm, kv_w_kr, kv_w_uk, kv_w_uv,
               mla_w_dq, mla_q_norm, mla_w_uq, mla_w_o,
               ffn_w_up, ffn_conv_w, ffn_conv_b, ffn_w_down)
    bp = x_prompt.shape[0]
    dtp = x_prompt.dtype
    y_prompt, p_ssm, p_ssm_conv, p_ffn_conv, p_lat, p_kpe = trunk(
        x_prompt,
        jnp.zeros((N_A, bp, SSM_CONV - 1, CONV_DIM), dtp),
        jnp.zeros((N_A, bp, SSM_HEADS, SSM_HEADDIM, D_STATE), dtp),
        jnp.zeros((DEPTH, bp, FFN_CONV - 1, 2 * D_FF), dtp),
        jnp.zeros((bp, 0, KV_RANK), dtp),
        jnp.zeros((bp, 0, QK_ROPE), dtp),
        weights)
    y_sample, s_ssm, s_ssm_conv, s_ffn_conv, s_lat, s_kpe = trunk(
        x_sample, state_ssm_conv, state_ssm, state_ffn_conv, cache_kv_latent, cache_k_rope, weights)
    return (y_prompt, y_sample, p_ssm, p_ssm_conv, p_ffn_conv, p_lat, p_kpe, s_ssm, s_ssm_conv, s_ffn_conv, s_lat, s_kpe)
```

```cpp
#include <hip/hip_runtime.h>
#include <hip/hip_cooperative_groups.h>
#include <cstdio>
#include <cstdint>
namespace cg = cooperative_groups;

#define LAS __attribute__((address_space(3)))
typedef unsigned short bf16_t;
typedef short bf16x8 __attribute__((ext_vector_type(8)));
typedef short bf16x4 __attribute__((ext_vector_type(4)));
typedef float f32x4 __attribute__((ext_vector_type(4)));
typedef float f32x2 __attribute__((ext_vector_type(2)));
typedef unsigned u32x4 __attribute__((ext_vector_type(4)));
typedef unsigned u32x2 __attribute__((ext_vector_type(2)));

constexpr int D_MODEL = 1024, NPROMPT_ROWS = 32768, MTOT = 34816;
constexpr int D_INNER = 2048, CONV_DIM = 3072, D_FF = 2816, D_FF2 = 5632;
constexpr float EPS = 1e-6f;
constexpr int NPH = 23;
constexpr size_t O_Y = 0, O_PSSM = 35651584, O_PSSMCONV = 39845888, O_PFFN = 39993344, O_PLAT = 40353792, O_PKPE = 48742400,
                 O_SSSM = 50839552, O_SSSMCONV = 59228160, O_SFFN = 59523072, O_SLAT = 60243968, O_SKPE = 60768256;
constexpr size_t WS_WIN = 0;
constexpr size_t WS_WOUT = WS_WIN + 5376ull * 1024 * 2;
constexpr size_t WS_WUP = WS_WOUT + 1024ull * 2048 * 2;
constexpr size_t WS_WDOWN = WS_WUP + 2ull * 5632 * 1024 * 2;
constexpr size_t WS_WKV = WS_WDOWN + 2ull * 1024 * 2816 * 2;
constexpr size_t WS_WDQ = WS_WKV + 512ull * 1024 * 2;
constexpr size_t WS_WUQ = WS_WDQ + 512ull * 1024 * 2;
constexpr size_t WS_WUK = WS_WUQ + 3072ull * 384 * 2;
constexpr size_t WS_WUV = WS_WUK + 4096ull * 128 * 2;
constexpr size_t WS_WO = WS_WUV + 2048ull * 640 * 2;
constexpr size_t WS_XN = WS_WO + 1024ull * 2048 * 2;
constexpr size_t WS_KC = WS_XN + 18432ull * 1024 * 2;
constexpr size_t WS_VT = WS_KC + 83968ull * 320 * 2;
constexpr size_t WS_BIG = WS_VT + 83968ull * 256 * 2;
constexpr size_t BIG_BYTES = 323223552ull;
constexpr size_t WS_END = WS_BIG + BIG_BYTES;
constexpr size_t MiB = 1u << 20;
constexpr size_t B_Z = 0, B_XBC = 75497472, B_DTP = 188743680, B_Y = 75497472;
constexpr size_t B_Y1A = 150994944;
constexpr size_t B_XST = 191102976, B_BC = 266600448, B_BT = 285474816, B_CC = 304349184;
constexpr size_t B_MIX0 = 0;
constexpr size_t B_U = 0, B_ACT = 207618048, B_F = 0;
constexpr size_t B_XNKV = 207618048, B_KVRAW = 100 * MiB, B_CQRAW = 144 * MiB;
constexpr size_t B_PART0 = 191102976, B_PART1 = 100 * MiB, B_PART2 = 200 * MiB;
constexpr size_t B_CQ = 0, B_QNOPE = 16 * MiB, B_QF = 100 * MiB, B_O2 = 16 * MiB, B_MIX1 = 100 * MiB;

constexpr int LDS_BYTES = 163840;
#ifndef PHASE_MASK
#define PHASE_MASK 0xFFFFFFFFu
#endif
#define PHM(x) (((PHASE_MASK) >> (x)) & 1u)

__device__ __forceinline__ unsigned f2bf(float f) { unsigned u = __builtin_bit_cast(unsigned, f); return (u + 0x7fffu + ((u >> 16) & 1u)) >> 16; }
__device__ __forceinline__ unsigned pk2(float lo, float hi) { unsigned r; asm("v_cvt_pk_bf16_f32 %0, %1, %2" : "=v"(r) : "v"(lo), "v"(hi)); return r; }
__device__ __forceinline__ float bf2f(unsigned h) { return __builtin_bit_cast(float, h << 16); }
__device__ __forceinline__ float bflo(unsigned w) { return __builtin_bit_cast(float, w << 16); }
__device__ __forceinline__ float bfhi(unsigned w) { return __builtin_bit_cast(float, w & 0xffff0000u); }
__device__ __forceinline__ float wave_sum(float v) {
#pragma unroll
    for (int o = 1; o < 64; o <<= 1) v += __shfl_xor(v, o);
    return v;
}
__device__ __forceinline__ float silu_f(float v) { return v * __builtin_amdgcn_rcpf(1.f + __expf(-v)); }
__device__ __forceinline__ float gelu_tanh_f(float v) { const float u = 0.7978845608f * (v + 0.044715f * v * v * v); return v * __builtin_amdgcn_rcpf(1.f + __expf(-2.f * u)); }
__device__ __forceinline__ float softplus_f(float x) { return fmaxf(x, 0.f) + log1pf(__expf(-fabsf(x))); }
__device__ __forceinline__ void sincos_rev(float ang, float& s, float& c) { float f = ang * 0.15915494309f; f = f - floorf(f); s = __builtin_amdgcn_sinf(f); c = __builtin_amdgcn_cosf(f); }
__device__ __forceinline__ void row_decode(int r, int& seq, int& t, int& T) {
    if (r < NPROMPT_ROWS) { seq = r >> 11; t = r & 2047; T = 2048; } else { const int q = r - NPROMPT_ROWS; seq = 16 + (q >> 6); t = q & 63; T = 64; }
}

namespace pg8 {
constexpr int BM = 256, BK = 64, HALF = 128, HTB = HALF * BK * 2, STAGE_BYTES = 8 * HTB, NXCD = 8, WGM = 8;
__host__ __device__ __forceinline__ int lds_byte(int r, int c) { const int st = (r >> 4) * 2 + (c >> 5), rr = r & 15, cc = c & 31, ob = rr * 64 + cc * 2; return st * 1024 + (ob ^ (((ob >> 9) & 1) << 5)); }
__host__ __device__ __forceinline__ void stage_rc(int b, int& R, int& C) { const int st = b / 1024, sb = b % 1024, swz = sb ^ (((sb >> 9) & 1) << 5); R = (st >> 1) * 16 + swz / 64; C = (st & 1) * 32 + (swz % 64) / 2; }
__host__ __device__ __forceinline__ int perm32(int rho) { const int n = rho >> 4, i = rho & 15; return 8 * (i >> 2) + 4 * n + (i & 3); }
struct Unit { int pm, pn; };
struct Gemm { const bf16_t* A; const bf16_t* Bt; int M, N, K, lda, ldb, a_pn_step, ncol, kpart; };
struct StaticOrder {
    int nM, nN, nwg, G, c;
    __device__ void init(int M, int N, int G_, int c_) { nM = M / BM; nN = N / BM; nwg = nM * nN; G = G_; c = c_; }
    __device__ bool next(int i, Unit& u) const {
        const long L = (long)i * G + c; if (L >= nwg) return false;
        int wgid = (int)L; { const int q = nwg / NXCD, r = nwg % NXCD, xcd = wgid % NXCD, off = wgid / NXCD; wgid = (xcd < r ? xcd * (q + 1) : r * (q + 1) + (xcd - r) * q) + off; }
        const int nig = WGM * nN, gid = wgid / nig, fm = gid * WGM, gsz = (nM - fm) < WGM ? (nM - fm) : WGM;
        u.pm = fm + ((wgid % nig) % gsz); u.pn = (wgid % nig) / gsz; return true;
    }
};
template <class Epi>
__device__ __forceinline__ void gemm_phase(LAS unsigned char* lds, const Gemm g, const StaticOrder& S, const Epi& E, const int tid) {
    const int wid = __builtin_amdgcn_readfirstlane(tid >> 6), lane = tid & 63, wr = wid >> 2, wc = wid & 3, fr = lane & 15, fq = lane >> 4;
    int K = g.K; asm volatile("" : "+s"(K)); K = __builtin_amdgcn_readfirstlane(K); const int nt = K / BK;
    unsigned voffA[2], voffB[2];
#pragma unroll
    for (int i = 0; i < 2; ++i) { int R, C; stage_rc(tid * 16 + i * 8192, R, C); const int Rb = Epi::PERM ? ((R & ~31) + perm32(R & 31)) : R;
        voffA[i] = (unsigned)(R * g.lda + C) * 2u; voffB[i] = (unsigned)(Rb * g.ldb + C) * 2u; }
    const size_t kstep = (size_t)(BK * 2);
    const size_t hstepA = (size_t)HALF * g.lda * 2, hstepB = (size_t)HALF * g.ldb * 2;
    const size_t tstepA = 2 * hstepA, tstepB = 2 * hstepB, pnstepA = (size_t)g.a_pn_step * 2;
    const unsigned ldsw = (unsigned)wid * 1024u;
    const int aoff = lds_byte(wr * 64 + fr, fq * 8), boff = lds_byte(wc * 32 + fr, fq * 8);
#define PG8_SA(b, h) (((b) * 2 + (h)) * HTB)
#define PG8_SB(b, h) ((4 + (b) * 2 + (h)) * HTB)
#define PG8_STAGE(bufoff, gbase, voff) do { _Pragma("unroll") for (int _i = 0; _i < 2; ++_i) \
        __builtin_amdgcn_global_load_lds((const unsigned*)((const char*)(gbase) + (voff)[_i]), (LAS unsigned*)(lds + (bufoff) + ldsw + _i * 8192), 16, 0, 0); } while (0)
#define PG8_LDA(dst, b, h) do { _Pragma("unroll") for (int m = 0; m < 4; ++m) _Pragma("unroll") for (int k = 0; k < 2; ++k) dst[m][k] = *(const LAS bf16x8*)(lds + PG8_SA(b, h) + aoff + m * 2048 + k * 1024); } while (0)
#define PG8_LDB(dst, b, h) do { _Pragma("unroll") for (int n = 0; n < 2; ++n) _Pragma("unroll") for (int k = 0; k < 2; ++k) dst[n][k] = *(const LAS bf16x8*)(lds + PG8_SB(b, h) + boff + n * 2048 + k * 1024); } while (0)
#define PG8_MMA(ai, bj, At, Bt) do { __builtin_amdgcn_s_setprio(1); _Pragma("unroll") for (int m = 0; m < 4; ++m) _Pragma("unroll") for (int n = 0; n < 2; ++n) _Pragma("unroll") for (int k = 0; k < 2; ++k) \
        acc[ai][bj][m][n] = __builtin_amdgcn_mfma_f32_16x16x32_bf16(Bt[n][k], At[m][k], acc[ai][bj][m][n], 0, 0, 0); __builtin_amdgcn_s_setprio(0); } while (0)
#define PG8_WAIT_V(n) asm volatile("s_waitcnt vmcnt(" #n ")" ::: "memory")
#define PG8_WAIT_L(n) asm volatile("s_waitcnt lgkmcnt(" #n ")" ::: "memory")
#define PG8_BAR __builtin_amdgcn_s_barrier()
#define PG8_SCHED __builtin_amdgcn_sched_barrier(0)
    Unit cur, nxt; int ui = 0;
    if (!S.next(0, cur)) return;
    f32x4 acc[2][2][4][2];
#pragma unroll
    for (int a = 0; a < 2; ++a)
#pragma unroll
        for (int b = 0; b < 2; ++b)
#pragma unroll
            for (int m = 0; m < 4; ++m)
#pragma unroll
                for (int n = 0; n < 2; ++n) acc[a][b][m][n] = (f32x4){0.f, 0.f, 0.f, 0.f};
    bf16x8 At[4][2], B0[2][2], B1[2][2];
#define PG8_OFFA(u) (g.ncol ? (size_t)(u).pm * tstepA + (size_t)((u).pn / g.ncol) * (size_t)g.kpart * 2 : (size_t)(u).pm * tstepA + (size_t)(u).pn * pnstepA)
#define PG8_OFFB(u) (g.ncol ? (size_t)((u).pn % g.ncol) * tstepB + (size_t)((u).pn / g.ncol) * (size_t)g.kpart * 2 : (size_t)(u).pn * tstepB)
    const char* cA = (const char*)g.A + PG8_OFFA(cur); const char* cB = (const char*)g.Bt + PG8_OFFB(cur);
    PG8_STAGE(PG8_SB(0, 0), cB, voffB); PG8_STAGE(PG8_SB(0, 1), cB + hstepB, voffB); PG8_STAGE(PG8_SA(0, 0), cA, voffA); PG8_STAGE(PG8_SA(0, 1), cA + hstepA, voffA);
    if (wr == 1) PG8_BAR;
    PG8_WAIT_V(2); PG8_BAR;
    PG8_STAGE(PG8_SB(1, 0), cB + kstep, voffB); PG8_STAGE(PG8_SA(1, 0), cA + kstep, voffA); PG8_STAGE(PG8_SB(1, 1), cB + hstepB + kstep, voffB);
    PG8_WAIT_V(6); PG8_BAR;
    for (;;) {
        const bool has_next = S.next(ui + 1, nxt);
        const char* nA = has_next ? (const char*)g.A + PG8_OFFA(nxt) : cA; const char* nB = has_next ? (const char*)g.Bt + PG8_OFFB(nxt) : cB;
        for (int t = 0; t < nt; t += 2) {
            const bool last = (t == nt - 2);
            const char* a1 = cA + (size_t)(t + 1) * kstep;
            const char* a2 = last ? nA : cA + (size_t)(t + 2) * kstep; const char* b2 = last ? nB : cB + (size_t)(t + 2) * kstep;
            const char* a3 = a2 + kstep; const char* b3 = b2 + kstep;
            PG8_LDB(B0, 0, 0); PG8_LDB(B1, 0, 1); PG8_SCHED; PG8_LDA(At, 0, 0); PG8_STAGE(PG8_SA(1, 1), a1 + hstepA, voffA);
            PG8_WAIT_V(8); PG8_WAIT_L(0); PG8_BAR; PG8_MMA(0, 0, At, B0); PG8_MMA(0, 1, At, B1); PG8_BAR; PG8_SCHED;
            PG8_LDA(At, 0, 1); PG8_STAGE(PG8_SB(0, 0), b2, voffB); PG8_STAGE(PG8_SB(0, 1), b2 + hstepB, voffB); PG8_STAGE(PG8_SA(0, 0), a2, voffA);
            PG8_WAIT_V(8); PG8_WAIT_L(0); PG8_BAR; PG8_MMA(1, 0, At, B0); PG8_MMA(1, 1, At, B1); PG8_BAR; PG8_SCHED;
            PG8_LDB(B0, 1, 0); PG8_LDB(B1, 1, 1); PG8_SCHED; PG8_LDA(At, 1, 0); PG8_STAGE(PG8_SA(0, 1), a2 + hstepA, voffA);
            PG8_WAIT_V(8); PG8_WAIT_L(0); PG8_BAR; PG8_MMA(0, 0, At, B0); PG8_MMA(0, 1, At, B1); PG8_BAR; PG8_SCHED;
            PG8_LDA(At, 1, 1); PG8_STAGE(PG8_SB(1, 0), b3, voffB); PG8_STAGE(PG8_SB(1, 1), b3 + hstepB, voffB); PG8_STAGE(PG8_SA(1, 0), a3, voffA);
            PG8_WAIT_V(8); PG8_WAIT_L(0); PG8_BAR; PG8_MMA(1, 0, At, B0); PG8_MMA(1, 1, At, B1); PG8_BAR; PG8_SCHED;
        }
        if (wr == 0) PG8_BAR;
        { int le; asm volatile("v_mbcnt_lo_u32_b32 %0, -1, 0\n\tv_mbcnt_hi_u32_b32 %0, -1, %0" : "=v"(le));
          E(acc, cur, wr, wc, le & 15, le >> 4); }
        if (!has_next) break;
#pragma unroll
        for (int a = 0; a < 2; ++a)
#pragma unroll
            for (int b = 0; b < 2; ++b)
#pragma unroll
                for (int m = 0; m < 4; ++m)
#pragma unroll
                    for (int n = 0; n < 2; ++n) acc[a][b][m][n] = (f32x4){0.f, 0.f, 0.f, 0.f};
        cur = nxt; cA = nA; cB = nB; ++ui;
        if (wr == 1) PG8_BAR;
    }
    PG8_WAIT_V(0);
    PG8_BAR;
#undef PG8_OFFA
#undef PG8_OFFB
#undef PG8_SA
#undef PG8_SB
#undef PG8_STAGE
#undef PG8_LDA
#undef PG8_LDB
#undef PG8_MMA
#undef PG8_WAIT_V
#undef PG8_WAIT_L
#undef PG8_BAR
#undef PG8_SCHED
}
}
using pg8::Unit;
typedef f32x4 Acc[2][2][4][2];

__device__ __forceinline__ u32x4 pack8(const f32x4 v0, const f32x4 v1) { u32x4 w; w.x = pk2(v0[0], v0[1]); w.y = pk2(v0[2], v0[3]); w.z = pk2(v1[0], v1[1]); w.w = pk2(v1[2], v1[3]); return w; }

struct EpiF32 { static constexpr bool PERM = false; float* O; int ldc;
    __device__ __forceinline__ void operator()(const Acc& acc, const Unit& u, int wr, int wc, int fr, int fq) const {
        const int row0 = u.pm * 256 + wr * 64 + fr, col0 = u.pn * 256 + wc * 32 + 4 * fq;
#pragma unroll
        for (int ai = 0; ai < 2; ++ai)
#pragma unroll
            for (int m = 0; m < 4; ++m) { float* rowp = O + (size_t)(row0 + ai * 128 + m * 16) * ldc + col0;
#pragma unroll
                for (int bj = 0; bj < 2; ++bj)
#pragma unroll
                    for (int n = 0; n < 2; ++n) *(f32x4*)(rowp + bj * 128 + n * 16) = acc[ai][bj][m][n]; }
    }
};
struct EpiF32Part { static constexpr bool PERM = false; float* O;
    __device__ __forceinline__ void operator()(const Acc& acc, const Unit& u, int wr, int wc, int fr, int fq) const {
        const int kp = u.pn >> 2, ct = u.pn & 3; const int row0 = u.pm * 256 + wr * 64 + fr, col0 = ct * 256 + wc * 32 + 4 * fq; float* base = O + (size_t)kp * 2048 * 1024;
#pragma unroll
        for (int ai = 0; ai < 2; ++ai)
#pragma unroll
            for (int m = 0; m < 4; ++m) { float* rowp = base + (size_t)(row0 + ai * 128 + m * 16) * 1024 + col0;
#pragma unroll
                for (int bj = 0; bj < 2; ++bj)
#pragma unroll
                    for (int n = 0; n < 2; ++n) *(f32x4*)(rowp + bj * 128 + n * 16) = acc[ai][bj][m][n]; }
    }
};
struct EpiBf16 { static constexpr bool PERM = true; bf16_t* O; int ldc; float* st_p; float* st_s; int m0;
    __device__ __forceinline__ void operator()(const Acc& acc, const Unit& u, int wr, int wc, int fr, int fq) const {
        const int row0 = u.pm * 256 + wr * 64 + fr, col0 = u.pn * 256 + wc * 32 + 8 * fq;
#pragma unroll
        for (int ai = 0; ai < 2; ++ai)
#pragma unroll
            for (int m = 0; m < 4; ++m) { const int lrow = row0 + ai * 128 + m * 16; bf16_t* rowp = O + (size_t)lrow * ldc + col0;
#pragma unroll
                for (int bj = 0; bj < 2; ++bj) *(u32x4*)(rowp + bj * 128) = pack8(acc[ai][bj][m][0], acc[ai][bj][m][1]);
                if (st_p) { int seq, t, T; row_decode(m0 + lrow, seq, t, T); const int idx = t - (T - 2);
                    if (idx >= 0) { float* o = (seq < 16 ? st_p + (size_t)(seq * 2 + idx) * D_FF2 : st_s + (size_t)((seq - 16) * 2 + idx) * D_FF2) + col0;
#pragma unroll
                        for (int bj = 0; bj < 2; ++bj) { *(f32x4*)(o + bj * 128) = acc[ai][bj][m][0]; *(f32x4*)(o + bj * 128 + 4) = acc[ai][bj][m][1]; } } }
            }
    }
};
struct EpiInProj { static constexpr bool PERM = true; bf16_t* Z; bf16_t* XBC; float* DTP; const float* dt_bias; float* out; int m0;
    __device__ __forceinline__ void operator()(const Acc& acc, const Unit& u, int wr, int wc, int fr, int fq) const {
        const int row0 = u.pm * 256 + wr * 64 + fr;
        if (u.pn < 20) {
            bf16_t* base; int ld, colt; const bool isx = u.pn >= 8;
            if (!isx) { base = Z; ld = 2048; colt = u.pn * 256; } else { base = XBC; ld = 3072; colt = (u.pn - 8) * 256; }
            const int col0 = colt + wc * 32 + 8 * fq;
#pragma unroll
            for (int ai = 0; ai < 2; ++ai)
#pragma unroll
                for (int m = 0; m < 4; ++m) { const int lrow = row0 + ai * 128 + m * 16; bf16_t* rowp = base + (size_t)lrow * ld + col0;
#pragma unroll
                    for (int bj = 0; bj < 2; ++bj) *(u32x4*)(rowp + bj * 128) = pack8(acc[ai][bj][m][0], acc[ai][bj][m][1]);
                    if (isx) { int seq, t, T; row_decode(m0 + lrow, seq, t, T); const int idx = t - (T - 3);
                        if (idx >= 0) { float* o = out + (seq < 16 ? O_PSSMCONV + (size_t)(seq * 3 + idx) * CONV_DIM : O_SSSMCONV + (size_t)((seq - 16) * 3 + idx) * CONV_DIM) + col0;
#pragma unroll
                            for (int bj = 0; bj < 2; ++bj) { *(f32x4*)(o + bj * 128) = acc[ai][bj][m][0]; *(f32x4*)(o + bj * 128 + 4) = acc[ai][bj][m][1]; } } }
                }
        } else if (wc == 0) {
#pragma unroll
            for (int ai = 0; ai < 2; ++ai)
#pragma unroll
                for (int m = 0; m < 4; ++m) { const int lrow = row0 + ai * 128 + m * 16;
#pragma unroll
                    for (int n = 0; n < 2; ++n) { const int h0 = 8 * fq + 4 * n; f32x4 v = acc[ai][0][m][n]; f32x4 o;
#pragma unroll
                        for (int j = 0; j < 4; ++j) o[j] = softplus_f(v[j] + dt_bias[h0 + j]);
                        *(f32x4*)(DTP + (size_t)lrow * 32 + h0) = o; } }
        }
    }
};
struct EpiUq { static constexpr bool PERM = true; bf16_t* QN; bf16_t* QF;
    __device__ __forceinline__ void operator()(const Acc& acc, const Unit& u, int wr, int wc, int fr, int fq) const {
        const int row0 = u.pm * 256 + wr * 64 + fr;
#pragma unroll
        for (int bj = 0; bj < 2; ++bj) { bf16_t* dst; size_t ld;
            if (u.pn < 8) { dst = QN + u.pn * 256 + bj * 128 + wc * 32 + 8 * fq; ld = 2048; }
            else { const int c = (u.pn - 8) * 256 + bj * 128 + wc * 32 + 8 * fq; dst = QF + (c >> 6) * 320 + 256 + (c & 63); ld = 5120; }
#pragma unroll
            for (int ai = 0; ai < 2; ++ai)
#pragma unroll
                for (int m = 0; m < 4; ++m) { const int lrow = row0 + ai * 128 + m * 16; *(u32x4*)(dst + (size_t)lrow * ld) = pack8(acc[ai][bj][m][0], acc[ai][bj][m][1]); } }
    }
};
struct EpiQlat { static constexpr bool PERM = true; bf16_t* QF; float scale;
    __device__ __forceinline__ void operator()(const Acc& acc, const Unit& u, int wr, int wc, int fr, int fq) const {
        const int row0 = u.pm * 256 + wr * 64 + fr, col0 = u.pn * 320 + wc * 32 + 8 * fq;
#pragma unroll
        for (int ai = 0; ai < 2; ++ai)
#pragma unroll
            for (int m = 0; m < 4; ++m) { bf16_t* rowp = QF + (size_t)(row0 + ai * 128 + m * 16) * 5120 + col0;
#pragma unroll
                for (int bj = 0; bj < 2; ++bj) *(u32x4*)(rowp + bj * 128) = pack8(acc[ai][bj][m][0] * scale, acc[ai][bj][m][1] * scale); }
    }
};

struct Params { const float* in[33]; float* out; unsigned char* ws; int ph_lo, ph_hi; };

__device__ __forceinline__ void transpose_item(const float* W, int N, bf16_t* WT, int ldo, int row_off, LAS float* scr, int item, int lane, const float* gk = nullptr) {
    const int nblk = N / 32, kb = item / nblk, nb = item % nblk, k0 = 64 * kb, n0 = 32 * nb;
#pragma unroll 8
    for (int i = 0; i < 32; ++i) { const int kk = 2 * i + (lane >> 5); float w = W[(size_t)(k0 + kk) * N + n0 + (lane & 31)]; if (gk) w *= gk[k0 + kk]; scr[kk * 33 + (lane & 31)] = w; }
    asm volatile("s_waitcnt lgkmcnt(0)" ::: "memory");
    const int c = lane & 7;
#pragma unroll
    for (int j = 0; j < 4; ++j) { const int n = (lane >> 3) + 8 * j; const LAS float* s = scr + (8 * c) * 33 + n;
        u32x4 o; o.x = pk2(s[0 * 33], s[1 * 33]); o.y = pk2(s[2 * 33], s[3 * 33]); o.z = pk2(s[4 * 33], s[5 * 33]); o.w = pk2(s[6 * 33], s[7 * 33]);
        *(u32x4*)(WT + (size_t)(row_off + n0 + n) * ldo + k0 + 8 * c) = o; }
    asm volatile("s_waitcnt lgkmcnt(0)" ::: "memory");
}


#define XB_TMO      128
#define XB_XCNT(j)  (256  + 64 * (j))
#define XB_XSUB(j)  (1280 + 64 * (j))
#define XB_XGEN(j)  (2304 + 64 * (j))
#define XB_TOP      3328
#define XB_TOPGEN   3392
#define XCD_BAR_WORDS 3456
#define XB_SPIN_CAP (1u << 18)
__device__ __forceinline__ unsigned xb_ld(unsigned* p)              { return __hip_atomic_load(p, __ATOMIC_RELAXED, __HIP_MEMORY_SCOPE_AGENT); }
__device__ __forceinline__ unsigned xb_add(unsigned* p, unsigned v) { return __hip_atomic_fetch_add(p, v, __ATOMIC_RELAXED, __HIP_MEMORY_SCOPE_AGENT); }
__device__ __forceinline__ unsigned xb_xcc_id() { return (unsigned)__builtin_amdgcn_s_getreg((3 << 11) | 20) & 0xFu; }
#define XB_SPIN(cond, bar) do { unsigned _sp = 0; while (cond) { __builtin_amdgcn_s_sleep(1); \
    if ((++_sp & 255u) == 0u) { if (xb_ld(&(bar)[XB_TMO])) break; if (_sp > XB_SPIN_CAP) { atomicAdd(&(bar)[XB_TMO], 1u); break; } } } } while (0)
struct XcdBarrier { unsigned* bar; unsigned x; volatile LAS unsigned* st; };
__device__ __forceinline__ void xcd_barrier_complete(unsigned* bar, unsigned x, unsigned& nloc, unsigned& nx) {
    const unsigned G = gridDim.x * gridDim.y * gridDim.z;
    unsigned sum, cnt, mine, sp = 0u;
    for (;;) {
        sum = 0u; cnt = 0u; mine = 0u;
#pragma unroll
        for (unsigned j = 0; j < 16; ++j) { const unsigned c = xb_ld(&bar[XB_XCNT(j)]); sum += c; cnt += (c > 0u) ? 1u : 0u; mine = (j == x) ? c : mine; }
        if (sum == G) break;
        __builtin_amdgcn_s_sleep(1);
        if ((++sp & 255u) == 0u) { if (xb_ld(&bar[XB_TMO])) break; if (sp > XB_SPIN_CAP) { atomicAdd(&bar[XB_TMO], 1u); break; } }
    }
    nloc = mine > 0u ? mine : 1u; nx = cnt > 0u ? cnt : 1u;
}
__device__ __forceinline__ void xcd_barrier(const XcdBarrier& b) {
    asm volatile("s_waitcnt vmcnt(0)" ::: "memory");
    __syncthreads();
    if (threadIdx.x == 0) {
        unsigned* bar = b.bar;
        __builtin_amdgcn_s_waitcnt(0);
        unsigned nloc = b.st[0], nx = b.st[1];
        if (nloc == 0u) { xcd_barrier_complete(bar, b.x, nloc, nx); b.st[0] = nloc; b.st[1] = nx; }
        const unsigned old = xb_add(&bar[XB_XSUB(b.x)], 1u);
        const unsigned gen = old / nloc;
        if (old + 1u == (gen + 1u) * nloc) {
            __builtin_amdgcn_fence(__ATOMIC_RELEASE, "agent");
            asm volatile("s_waitcnt vmcnt(0)" ::: "memory");
            const unsigned og = xb_add(&bar[XB_TOP], 1u);
            const unsigned tg = og / nx;
            if (og + 1u == (tg + 1u) * nx) xb_add(&bar[XB_TOPGEN], 1u);
            else XB_SPIN(xb_ld(&bar[XB_TOPGEN]) == tg, bar);
            __builtin_amdgcn_fence(__ATOMIC_ACQUIRE, "agent");
            xb_add(&bar[XB_XGEN(b.x)], 1u);
            asm volatile("s_waitcnt vmcnt(0)" ::: "memory");
        } else {
            XB_SPIN(xb_ld(&bar[XB_XGEN(b.x)]) == gen, bar);
            __builtin_amdgcn_fence(__ATOMIC_ACQUIRE, "agent");
            asm volatile("s_waitcnt vmcnt(0)" ::: "memory");
        }
    }
    __syncthreads();
}
constexpr size_t WS_CTL = WS_END;
constexpr size_t CTL_BYTES = 16384;
constexpr int LDS_MISC = 163840 - 64;

__global__ void __launch_bounds__(512, 2) mk_fwd(Params P) {
    extern __shared__ __attribute__((aligned(16))) unsigned char lds_raw[];
    LAS unsigned char* lds = (LAS unsigned char*)lds_raw;
    cg::grid_group grid = cg::this_grid();
    const int ph_lo = P.ph_lo, ph_hi = P.ph_hi;
    if (threadIdx.x < 2) ((volatile LAS unsigned*)(lds + LDS_MISC))[threadIdx.x] = 0u;
    __syncthreads();
    if (threadIdx.x == 0) (void)xb_add((unsigned*)(P.ws + WS_CTL) + XB_XCNT(xb_xcc_id()), 1u);
    if (ph_hi == -12345) grid.sync();
    const int wave_s = __builtin_amdgcn_readfirstlane(threadIdx.x >> 6);
    for (int ph = ph_lo; ph < ph_hi; ++ph) {
        const __attribute__((address_space(4))) Params* pp; { unsigned long long v = (unsigned long long)__builtin_amdgcn_kernarg_segment_ptr(); asm volatile("" : "+s"(v));
            const unsigned lo = __builtin_amdgcn_readfirstlane((unsigned)v), hi = __builtin_amdgcn_readfirstlane((unsigned)(v >> 32)); pp = (const __attribute__((address_space(4))) Params*)(((unsigned long long)hi << 32) | lo); }
        int lane_o; asm volatile("v_mbcnt_lo_u32_b32 %0, -1, 0\n\tv_mbcnt_hi_u32_b32 %0, -1, %0" : "=v"(lane_o));
        const int tid = wave_s * 64 + lane_o;
        int bx = blockIdx.x; asm volatile("" : "+s"(bx)); bx = __builtin_amdgcn_readfirstlane(bx);
        int G = gridDim.x; asm volatile("" : "+s"(G)); G = __builtin_amdgcn_readfirstlane(G);
        unsigned char* ws = pp->ws;
        float* out = pp->out;
        const int lane = lane_o & 63, wave = wave_s;
        const int gw = bx * 8 + wave, NGW = G * 8;
        const int fr = lane & 15, fq = lane >> 4;
        bf16_t* WT_in = (bf16_t*)(ws + WS_WIN); bf16_t* WT_out = (bf16_t*)(ws + WS_WOUT); bf16_t* WT_up = (bf16_t*)(ws + WS_WUP); bf16_t* WT_down = (bf16_t*)(ws + WS_WDOWN);
        bf16_t* WT_kv = (bf16_t*)(ws + WS_WKV); bf16_t* WT_dq = (bf16_t*)(ws + WS_WDQ); bf16_t* WT_uq = (bf16_t*)(ws + WS_WUQ); bf16_t* WUK = (bf16_t*)(ws + WS_WUK);
        bf16_t* WUV = (bf16_t*)(ws + WS_WUV); bf16_t* WT_o = (bf16_t*)(ws + WS_WO);
        bf16_t* XN = (bf16_t*)(ws + WS_XN); bf16_t* KC = (bf16_t*)(ws + WS_KC); bf16_t* VT = (bf16_t*)(ws + WS_VT);
        unsigned char* big = ws + WS_BIG;
        bf16_t* KCS = KC + 8ull * 2048 * 320; bf16_t* VTS = VT + 8ull * 256 * 2048;
#ifndef DUP_PHASE
#define DUP_PHASE -1
#endif
#ifndef NULLPH
#define NULLPH 0
#endif
        constexpr int NPHQ = NPH + (DUP_PHASE >= 0 ? 1 : 0) + NULLPH;
        const int pass = ph / NPHQ; int kq = ph - pass * NPHQ;
        if (DUP_PHASE >= 0 && kq > DUP_PHASE) kq -= 1;
        const int k = kq >= NPH ? 999 : (kq <= 2 ? kq : (kq == 3 ? 100 : kq - 1));
        const int m0 = pass ? 16384 : 0, Mh = pass ? 18432 : 16384;
        pg8::StaticOrder S;
        if (k == 0 && PHM(0)) { asm volatile("; ==PHASE 0");
            LAS float* scr = (LAS float*)(lds + wave * 16384);
            if (pass == 0) {
                constexpr int I_IN = 16 * 161, I_OUT = 32 * 32, I_UP = 16 * 176, I_DOWN = 44 * 32, I_DKV = 16 * 8, I_KR = 16 * 2, I_DQ = 16 * 12, I_UQ = 6 * 96, I_O = 32 * 32;
                constexpr int NIT = I_IN + I_OUT + 2 * I_UP + 2 * I_DOWN + I_DKV + I_KR + I_DQ + I_UQ + I_O;
                for (int it = gw; it < NIT; it += NGW) {
                    int r = it;
                    if (r < I_IN) { transpose_item(pp->in[11], 5152, WT_in, 1024, 0, scr, r, lane); continue; } r -= I_IN;
                    if (r < I_OUT) { transpose_item(pp->in[18], 1024, WT_out, 2048, 0, scr, r, lane); continue; } r -= I_OUT;
                    if (r < I_UP) { transpose_item(pp->in[29], 5632, WT_up, 1024, 0, scr, r, lane); continue; } r -= I_UP;
                    if (r < I_UP) { transpose_item(pp->in[29] + 1024ull * 5632, 5632, WT_up + 5632ull * 1024, 1024, 0, scr, r, lane); continue; } r -= I_UP;
                    if (r < I_DOWN) { transpose_item(pp->in[32], 1024, WT_down, 2816, 0, scr, r, lane); continue; } r -= I_DOWN;
                    if (r < I_DOWN) { transpose_item(pp->in[32] + 2816ull * 1024, 1024, WT_down + 1024ull * 2816, 2816, 0, scr, r, lane); continue; } r -= I_DOWN;
                    if (r < I_DKV) { transpose_item(pp->in[20], 256, WT_kv, 1024, 0, scr, r, lane, pp->in[19]); continue; } r -= I_DKV;
                    if (r < I_KR) { transpose_item(pp->in[22], 64, WT_kv, 1024, 256, scr, r, lane, pp->in[19]); continue; } r -= I_KR;
                    if (r < I_DQ) { transpose_item(pp->in[25], 384, WT_kv, 1024, 320, scr, r, lane, pp->in[7] + 1024); continue; } r -= I_DQ;
                    if (r < I_UQ) { const int n0 = (r % 96) * 32, hh = n0 / 192, ww = n0 - hh * 192; const int dest = ww < 128 ? hh * 128 + ww : 2048 + hh * 64 + (ww - 128);
                        transpose_item(pp->in[27], 3072, WT_uq, 384, dest - n0, scr, r, lane); continue; } r -= I_UQ;
                    transpose_item(pp->in[28], 1024, WT_o, 2048, 0, scr, r, lane);
                }
                const size_t gt = (size_t)bx * 512 + tid, NT = (size_t)G * 512;
                for (size_t i = gt; i < 4096ull * 128; i += NT) { const int d = i & 127, n = (int)(i >> 7), h = n >> 8, r = n & 255; WUK[i] = (bf16_t)f2bf(pp->in[23][((size_t)r * 16 + h) * 128 + d]); }
                for (size_t i = gt; i < 2048ull * 640; i += NT) { const int kk = (int)(i % 640), n = (int)(i / 640), hp = n >> 8, j = (n >> 7) & 1, v = n & 127; const int r = kk - j * 320;
                    WUV[i] = (r >= 0 && r < 256) ? (bf16_t)f2bf(pp->in[24][((size_t)r * 16 + 2 * hp + j) * 128 + v]) : (bf16_t)0; }
            } else {
                const size_t gt = (size_t)bx * 512 + tid, NT = (size_t)G * 512;
                for (size_t i = gt; i < 32ull * 2048 * 40; i += NT) { const int cv = (int)(i % 40); const size_t rk = i / 40; const int sb = (int)(rk >> 11), key = (int)(rk & 2047);
                    const float* src = cv < 32 ? pp->in[5] + rk * 256 + cv * 8 : pp->in[6] + rk * 64 + (cv - 32) * 8;
                    const f32x4 a = *(const f32x4*)src, b = *(const f32x4*)(src + 4);
                    *(u32x4*)(KCS + ((size_t)sb * 2112 + key) * 320 + cv * 8) = pack8(a, b); }
            }
            const float* g = pp->in[7];
            for (int lrb = gw; lrb < Mh; lrb += 4 * NGW) { f32x4 v[4][4];
#pragma unroll
                for (int q = 0; q < 4; ++q) { const int lr = min(lrb + q * NGW, Mh - 1), r = m0 + lr; const float* xi = r < NPROMPT_ROWS ? pp->in[0] + (size_t)r * 1024 : pp->in[1] + (size_t)(r - NPROMPT_ROWS) * 1024;
#pragma unroll
                    for (int j = 0; j < 4; ++j) v[q][j] = ((const f32x4*)xi)[lane + 64 * j]; }
#pragma unroll
                for (int q = 0; q < 4; ++q) { const int lr = lrb + q * NGW; if (lr < Mh) { float ss = 0.f;
#pragma unroll
                    for (int j = 0; j < 4; ++j) ss += v[q][j][0] * v[q][j][0] + v[q][j][1] * v[q][j][1] + v[q][j][2] * v[q][j][2] + v[q][j][3] * v[q][j][3];
                    const float rr = __builtin_amdgcn_rsqf(wave_sum(ss) * (1.f / 1024.f) + EPS);
#pragma unroll
                    for (int j = 0; j < 4; ++j) { const f32x4 gg = ((const f32x4*)g)[lane + 64 * j]; u32x2 o; o.x = pk2(v[q][j][0] * rr * gg[0], v[q][j][1] * rr * gg[1]); o.y = pk2(v[q][j][2] * rr * gg[2], v[q][j][3] * rr * gg[3]);
                        ((u32x2*)(XN + (size_t)lr * 1024))[lane + 64 * j] = o; } } } }
        } else if (k == 1 && PHM(1)) { asm volatile("; ==PHASE 1");
            pg8::Gemm g{XN, WT_in, Mh, 5376, 1024, 1024, 1024, 0, 0, 0}; S.init(Mh, 5376, G, bx);
            EpiInProj E{(bf16_t*)(big + B_Z), (bf16_t*)(big + B_XBC), (float*)(big + B_DTP), pp->in[14], out, m0};
            pg8::gemm_phase<EpiInProj>(lds, g, S, E, tid);
        } else if (k == 2 && PHM(2)) { asm volatile("; ==PHASE 2");
            const bf16_t* XBC = (const bf16_t*)(big + B_XBC);
            bf16_t* XST = (bf16_t*)(big + B_XST); bf16_t* BC = (bf16_t*)(big + B_BC); bf16_t* BTg = (bf16_t*)(big + B_BT); bf16_t* CC = (bf16_t*)(big + B_CC);
            const float* cwg = pp->in[12]; const float* cbg = pp->in[13]; const float* stc = pp->in[3];
            LAS bf16_t* Tt = (LAS bf16_t*)lds;
            const int nun = (Mh / 64) * 48;
            const int l = tid >> 3, oc = tid & 7;
            for (int un0 = bx; un0 < nun; un0 += 3 * G) {
                u32x4 ov[3]; int cls[3], jbs[3];
                float rw[3][4][8];
#pragma unroll
                for (int q = 0; q < 3; ++q) { const int un = min(un0 + q * G, nun - 1); const int cl = un / 48, jb = un - cl * 48; const int c0 = jb * 64 + oc * 8; cls[q] = cl; jbs[q] = jb;
                    int seq, t0, T; row_decode(m0 + cl * 64, seq, t0, T);
#pragma unroll
                    for (int i = 0; i < 4; ++i) { const int t = t0 + l - 3 + i;
                        if (t >= 0) { const u32x4 w = *(const u32x4*)(XBC + (size_t)(cl * 64 + l - 3 + i) * CONV_DIM + c0);
#pragma unroll
                            for (int e = 0; e < 4; ++e) { rw[q][i][2 * e] = bflo(w[e]); rw[q][i][2 * e + 1] = bfhi(w[e]); } }
                        else if (seq >= 16) { const float* sp = stc + ((size_t)(seq - 16) * 3 + (3 + t)) * CONV_DIM + c0; const f32x4 a = *(const f32x4*)sp, b = *(const f32x4*)(sp + 4);
#pragma unroll
                            for (int e = 0; e < 4; ++e) { rw[q][i][e] = a[e]; rw[q][i][4 + e] = b[e]; } }
                        else {
#pragma unroll
                            for (int e = 0; e < 8; ++e) rw[q][i][e] = 0.f; } } }
#pragma unroll
                for (int q = 0; q < 3; ++q) { const int c0 = jbs[q] * 64 + oc * 8; float o[8];
                    { const f32x4 b0 = *(const f32x4*)(cbg + c0), b1 = *(const f32x4*)(cbg + c0 + 4);
#pragma unroll
                      for (int e = 0; e < 4; ++e) { o[e] = b0[e]; o[4 + e] = b1[e]; } }
#pragma unroll
                    for (int i = 0; i < 4; ++i) { const f32x4 w0 = *(const f32x4*)(cwg + (size_t)i * CONV_DIM + c0), w1 = *(const f32x4*)(cwg + (size_t)i * CONV_DIM + c0 + 4);
#pragma unroll
                        for (int e = 0; e < 4; ++e) { o[e] += w0[e] * rw[q][i][e]; o[4 + e] += w1[e] * rw[q][i][4 + e]; } }
#pragma unroll
                    for (int e = 0; e < 8; ++e) o[e] = silu_f(o[e]);
                    ov[q].x = pk2(o[0], o[1]); ov[q].y = pk2(o[2], o[3]); ov[q].z = pk2(o[4], o[5]); ov[q].w = pk2(o[6], o[7]); }
                __syncthreads();
#pragma unroll
                for (int q = 0; q < 3; ++q) { const bool valid = un0 + q * G < nun; const int cl = cls[q], jb = jbs[q];
                    if (valid && jb >= 40) *(u32x4*)(CC + (size_t)(cl * 64 + l) * 512 + (jb - 40) * 64 + oc * 8) = ov[q];
                    if (valid && jb >= 32 && jb < 40) *(u32x4*)(BC + (size_t)(cl * 64 + l) * 512 + (jb - 32) * 64 + oc * 8) = ov[q];
#pragma unroll
                    for (int e = 0; e < 4; ++e) { Tt[q * 4480 + (oc * 8 + 2 * e) * 70 + l] = (bf16_t)(ov[q][e] & 0xffff); Tt[q * 4480 + (oc * 8 + 2 * e + 1) * 70 + l] = (bf16_t)(ov[q][e] >> 16); } }
                __syncthreads();
#pragma unroll
                for (int q = 0; q < 3; ++q) { const bool valid = un0 + q * G < nun; const int cl = cls[q], jb = jbs[q];
                    if (valid && jb < 40) { const int c = tid >> 3, lv = tid & 7; u32x4 tv;
#pragma unroll
                        for (int e = 0; e < 4; ++e) tv[e] = *(const LAS unsigned*)(Tt + q * 4480 + c * 70 + lv * 8 + 2 * e);
                        bf16_t* d = jb < 32 ? XST + (((size_t)cl * 32 + jb) * 64 + c) * 64 + lv * 8 : BTg + (((size_t)cl * 4 + ((jb - 32) >> 1)) * 128 + ((jb - 32) & 1) * 64 + c) * 64 + lv * 8;
                        *(u32x4*)d = tv; } }
            }
        } else if (k == 100 && PHM(2)) { asm volatile("; ==PHASE 100");
            const int Hh = G >> 1;
            if (bx >= Hh) {
            const bf16_t* XST = (const bf16_t*)(big + B_XST); const bf16_t* BC = (const bf16_t*)(big + B_BC); const bf16_t* CC = (const bf16_t*)(big + B_CC);
            const float* DTP = (const float*)(big + B_DTP); bf16_t* Y1a = (bf16_t*)(big + B_Y1A); bf16_t* Y1b = (bf16_t*)(ws + WS_VT); const int Mhh = Mh >> 1;
            LAS bf16_t* Bm = (LAS bf16_t*)(lds);
            LAS bf16_t* Cm = (LAS bf16_t*)(lds + 17408);
            LAS bf16_t* xsT = (LAS bf16_t*)(lds + 34816);
            LAS float* sdt = (LAS float*)(lds + 108544);
            LAS float* sacs = sdt + 512;
            const int nun = (Mh / 64) * 4;
            for (int un = bx - Hh; un < nun; un += G - Hh) { const int cl = un >> 2, grp = un & 3; const int h = grp * 8 + wave;
                const float Ah = -__expf(pp->in[15][h]), Dh = pp->in[16][h];
                __syncthreads();
#pragma unroll
                for (int i = 0; i < 2; ++i) { const int v = tid + 512 * i, r = v >> 4, cv = v & 15; *(LAS u32x4*)(Bm + r * 136 + cv * 8) = *(const u32x4*)(BC + (size_t)(cl * 64 + r) * 512 + grp * 128 + cv * 8);
                    *(LAS u32x4*)(Cm + r * 136 + cv * 8) = *(const u32x4*)(CC + (size_t)(cl * 64 + r) * 512 + grp * 128 + cv * 8); }
#pragma unroll
                for (int i = 0; i < 8; ++i) { const int p = tid >> 3, lv = tid & 7; *(LAS u32x4*)(xsT + (i * 64 + p) * 72 + lv * 8) = *(const u32x4*)(XST + ((size_t)cl * 32 + grp * 8 + i) * 4096 + (size_t)tid * 8); }
                { const float dt = DTP[(size_t)(cl * 64 + lane) * 32 + h]; float a = dt * Ah;
#pragma unroll
                  for (int o = 1; o < 64; o <<= 1) { const float tv = __shfl_up(a, o); if (lane >= o) a += tv; }
                  sdt[wave * 64 + lane] = dt; sacs[wave * 64 + lane] = a; }
                __syncthreads();
                LAS const float* acs = sacs + wave * 64; LAS const float* dts = sdt + wave * 64; LAS const bf16_t* xh = xsT + wave * 64 * 72;
#pragma unroll
                for (int lb = 0; lb < 4; ++lb) { const int l_idx = lb * 16 + fr; const float acs_l = acs[l_idx];
                    f32x4 cb[4];
#pragma unroll
                    for (int sb = 0; sb < 4; ++sb) cb[sb] = (f32x4){0.f, 0.f, 0.f, 0.f};
#pragma unroll
                    for (int ks = 0; ks < 4; ++ks) { const bf16x8 bfr = *(const LAS bf16x8*)(Cm + l_idx * 136 + ks * 32 + fq * 8);
#pragma unroll
                        for (int sb = 0; sb < 4; ++sb) if (sb <= lb) { const bf16x8 afr = *(const LAS bf16x8*)(Bm + (sb * 16 + fr) * 136 + ks * 32 + fq * 8); cb[sb] = __builtin_amdgcn_mfma_f32_16x16x32_bf16(afr, bfr, cb[sb], 0, 0, 0); } }
                    bf16x8 wl[2];
#pragma unroll
                    for (int sb = 0; sb < 4; ++sb) { float wv[4];
#pragma unroll
                        for (int i = 0; i < 4; ++i) { const int sidx = sb * 16 + fq * 4 + i; wv[i] = (sb <= lb && sidx <= l_idx) ? cb[sb][i] * __expf(acs_l - acs[sidx]) * dts[sidx] : 0.f; }
                        const unsigned u0 = pk2(wv[0], wv[1]), u1 = pk2(wv[2], wv[3]); const int tt = sb >> 1, hf = sb & 1;
                        wl[tt][hf * 4 + 0] = (short)(u0 & 0xffff); wl[tt][hf * 4 + 1] = (short)(u0 >> 16); wl[tt][hf * 4 + 2] = (short)(u1 & 0xffff); wl[tt][hf * 4 + 3] = (short)(u1 >> 16); }
#pragma unroll
                    for (int pb = 0; pb < 4; ++pb) { f32x4 y = (f32x4){0.f, 0.f, 0.f, 0.f};
#pragma unroll
                        for (int tt = 0; tt < 2; ++tt) if (2 * tt <= lb) { const bf16x4 a0 = *(const LAS bf16x4*)(xh + (pb * 16 + fr) * 72 + 32 * tt + fq * 4), a1 = *(const LAS bf16x4*)(xh + (pb * 16 + fr) * 72 + 32 * tt + 16 + fq * 4);
                            const bf16x8 afr = (bf16x8){a0[0], a0[1], a0[2], a0[3], a1[0], a1[1], a1[2], a1[3]};
                            y = __builtin_amdgcn_mfma_f32_16x16x32_bf16(afr, wl[tt], y, 0, 0, 0); }
#pragma unroll
                        for (int i = 0; i < 4; ++i) y[i] += bf2f(xh[(pb * 16 + fq * 4 + i) * 72 + l_idx]) * Dh;
                        u32x2 o; o.x = pk2(y[0], y[1]); o.y = pk2(y[2], y[3]);
                        const int lr1 = cl * 64 + l_idx; bf16_t* y1 = lr1 < Mhh ? Y1a + (size_t)lr1 * D_INNER : Y1b + (size_t)(lr1 - Mhh) * D_INNER;
                        *(u32x2*)(y1 + h * 64 + pb * 16 + fq * 4) = o; } }
            }
            }
            {
            const bf16_t* XST = (const bf16_t*)(big + B_XST); const bf16_t* BTg = (const bf16_t*)(big + B_BT); const bf16_t* CC = (const bf16_t*)(big + B_CC);
            const float* DTP = (const float*)(big + B_DTP); bf16_t* Y = (bf16_t*)(big + B_Y);
            const int hl = wave >> 2, pq = wave & 3;
            const int nunits = pass ? 128 + 512 : 128;
            const int npr = bx < Hh ? (128 - bx + Hh - 1) / Hh : 0;
            for (int it = 0; ; ++it) { const int un = it < npr ? bx + it * Hh : 128 + bx + (it - npr) * G; if (un >= nunits) break;
                int seq, grp, hp;
                if (un < 128) { seq = (pass ? 8 : 0) + (un >> 4); grp = (un >> 2) & 3; hp = un & 3; } else { const int q = un - 128; seq = 16 + (q >> 4); grp = (q >> 2) & 3; hp = q & 3; }
                const bool smp = seq >= 16; const int nch = smp ? 1 : 32;
                const int lrow_base = (smp ? NPROMPT_ROWS + (seq - 16) * 64 : seq * 2048) - m0; const int cl_base = lrow_base >> 6;
                const int h = grp * 8 + hp * 2 + hl;
                const float Aw = -__expf(pp->in[15][grp * 8 + hp * 2 + (wave & 1)]);
                f32x4 st[8];
                { const float* sp = pp->in[2] + (((size_t)(smp ? seq - 16 : 0) * 32 + h) * 64 + pq * 16 + fr) * 128 + fq * 4;
#pragma unroll
                  for (int nb = 0; nb < 8; ++nb) { const f32x4 v = *(const f32x4*)(sp + nb * 16); st[nb] = smp ? v : (f32x4){0.f, 0.f, 0.f, 0.f}; } }
                u32x4 pf[6]; float pdt = 0.f; u32x2 yres[4];
#pragma unroll
                for (int lb = 0; lb < 4; ++lb) yres[lb] = (u32x2){0u, 0u};
#define SSD_PREFETCH(c_) do { const int c__ = (c_); const size_t rb_ = (size_t)(lrow_base + c__ * 64); \
                    _Pragma("unroll") for (int i = 0; i < 2; ++i) { const int v = tid + 512 * i, r = v >> 4, cv = v & 15; pf[i] = *(const u32x4*)(CC + (rb_ + r) * 512 + grp * 128 + cv * 8); \
                        pf[2 + i] = *(const u32x4*)(BTg + ((size_t)(cl_base + c__) * 4 + grp) * 8192 + (size_t)v * 8); \
                        pf[4 + i] = *(const u32x4*)(XST + ((size_t)(cl_base + c__) * 32 + grp * 8 + hp * 2 + i) * 4096 + (size_t)tid * 8); } \
                    if (wave < 2) pdt = DTP[(rb_ + lane) * 32 + grp * 8 + hp * 2 + wave]; } while (0)
#define SSD_WRITE(sg_) do { LAS unsigned char* sb_ = lds + (sg_) * 55296; LAS bf16_t* Cm_ = (LAS bf16_t*)sb_; LAS bf16_t* BT_ = (LAS bf16_t*)(sb_ + 17408); LAS bf16_t* xs_ = (LAS bf16_t*)(sb_ + 35840); LAS float* sa_ = (LAS float*)(sb_ + 54272); \
                    _Pragma("unroll") for (int i = 0; i < 2; ++i) { const int v = tid + 512 * i, r = v >> 4, cv = v & 15; *(LAS u32x4*)(Cm_ + r * 136 + cv * 8) = pf[i]; \
                        const int n = v >> 3, lv = v & 7; *(LAS u32x4*)(BT_ + n * 72 + lv * 8) = pf[2 + i]; \
                        const int p = tid >> 3, l8 = tid & 7; *(LAS u32x4*)(xs_ + (i * 64 + p) * 72 + l8 * 8) = pf[4 + i]; } \
                    if (wave < 2) { float a = pdt * Aw; \
                        _Pragma("unroll") for (int o = 1; o < 64; o <<= 1) { const float tv = __shfl_up(a, o); if (lane >= o) a += tv; } \
                        const float tot = __shfl(a, 63); \
                        sa_[wave * 64 + lane] = a; sa_[128 + wave * 64 + lane] = __expf(tot - a) * pdt; } } while (0)
                __syncthreads();
                SSD_PREFETCH(0);
                SSD_WRITE(0);
                SSD_PREFETCH((nch > 1 ? 1 : 0));
                __syncthreads();
                for (int c = 0; c < nch; ++c) {
                    if (c + 1 < nch) SSD_WRITE((c + 1) & 1);
                    if (c + 2 < nch) SSD_PREFETCH(c + 2);
                    if (c > 0) {
#pragma unroll
                        for (int lb = 0; lb < 4; ++lb) *(u32x2*)(Y + (size_t)(lrow_base + (c - 1) * 64 + lb * 16 + fr) * D_INNER + h * 64 + pq * 16 + fq * 4) = yres[lb]; }
                    LAS unsigned char* sbase = lds + (c & 1) * 55296;
                    LAS const bf16_t* Cm = (LAS const bf16_t*)sbase; LAS const bf16_t* BTl = (LAS const bf16_t*)(sbase + 17408); LAS const bf16_t* xsT = (LAS const bf16_t*)(sbase + 35840);
                    LAS const float* sacs = (LAS const float*)(sbase + 54272); LAS const float* sw = sacs + 128;
                    LAS const float* acs = sacs + hl * 64; LAS const float* sws = sw + hl * 64;
                    LAS const bf16_t* xh = xsT + hl * 64 * 72;
                    f32x4 ya[4];
#pragma unroll
                    for (int lb = 0; lb < 4; ++lb) ya[lb] = (f32x4){0.f, 0.f, 0.f, 0.f};
#pragma unroll
                    for (int tt = 0; tt < 4; ++tt) { const unsigned u0 = pk2(st[2 * tt][0], st[2 * tt][1]), u1 = pk2(st[2 * tt][2], st[2 * tt][3]), u2 = pk2(st[2 * tt + 1][0], st[2 * tt + 1][1]), u3 = pk2(st[2 * tt + 1][2], st[2 * tt + 1][3]);
                        const bf16x8 af = (bf16x8){(short)(u0 & 0xffff), (short)(u0 >> 16), (short)(u1 & 0xffff), (short)(u1 >> 16), (short)(u2 & 0xffff), (short)(u2 >> 16), (short)(u3 & 0xffff), (short)(u3 >> 16)};
#pragma unroll
                        for (int lb = 0; lb < 4; ++lb) { const bf16x4 b0 = *(const LAS bf16x4*)(Cm + (lb * 16 + fr) * 136 + 32 * tt + fq * 4), b1 = *(const LAS bf16x4*)(Cm + (lb * 16 + fr) * 136 + 32 * tt + 16 + fq * 4);
                            const bf16x8 bfr = (bf16x8){b0[0], b0[1], b0[2], b0[3], b1[0], b1[1], b1[2], b1[3]};
                            ya[lb] = __builtin_amdgcn_mfma_f32_16x16x32_bf16(af, bfr, ya[lb], 0, 0, 0); } }
#pragma unroll
                    for (int lb = 0; lb < 4; ++lb) { const float eal = __expf(acs[lb * 16 + fr]); const f32x4 y = ya[lb] * eal; u32x2 o;
                        o.x = pk2(y[0], y[1]); o.y = pk2(y[2], y[3]); yres[lb] = o; }
                    { const float dec = __expf(acs[63]);
#pragma unroll
                      for (int nb = 0; nb < 8; ++nb) st[nb] = st[nb] * dec;
#pragma unroll
                      for (int tt = 0; tt < 2; ++tt) { const f32x4 s0 = *(const LAS f32x4*)(sws + tt * 32 + fq * 8), s1 = *(const LAS f32x4*)(sws + tt * 32 + fq * 8 + 4);
                          const u32x4 xv = *(const LAS u32x4*)(xh + (pq * 16 + fr) * 72 + tt * 32 + fq * 8);
                          const unsigned u0 = pk2(bflo(xv[0]) * s0[0], bfhi(xv[0]) * s0[1]), u1 = pk2(bflo(xv[1]) * s0[2], bfhi(xv[1]) * s0[3]), u2 = pk2(bflo(xv[2]) * s1[0], bfhi(xv[2]) * s1[1]), u3 = pk2(bflo(xv[3]) * s1[2], bfhi(xv[3]) * s1[3]);
                          const bf16x8 xb = (bf16x8){(short)(u0 & 0xffff), (short)(u0 >> 16), (short)(u1 & 0xffff), (short)(u1 >> 16), (short)(u2 & 0xffff), (short)(u2 >> 16), (short)(u3 & 0xffff), (short)(u3 >> 16)};
#pragma unroll
                          for (int nb = 0; nb < 8; ++nb) { const bf16x8 afr = *(const LAS bf16x8*)(BTl + (nb * 16 + fr) * 72 + tt * 32 + fq * 8); st[nb] = __builtin_amdgcn_mfma_f32_16x16x32_bf16(afr, xb, st[nb], 0, 0, 0); } } }
                    __syncthreads();
                }
#undef SSD_WRITE
#undef SSD_PREFETCH
#pragma unroll
                for (int lb = 0; lb < 4; ++lb) *(u32x2*)(Y + (size_t)(lrow_base + (nch - 1) * 64 + lb * 16 + fr) * D_INNER + h * 64 + pq * 16 + fq * 4) = yres[lb];
                float* so = out + (smp ? O_SSSM + ((size_t)(seq - 16) * 32 + h) * 8192 : O_PSSM + ((size_t)seq * 32 + h) * 8192);
#pragma unroll
                for (int nb = 0; nb < 8; ++nb) *(f32x4*)(so + (pq * 16 + fr) * 128 + nb * 16 + fq * 4) = st[nb];
            }
            }
        } else if (k == 3 && PHM(3)) { asm volatile("; ==PHASE 3");
            const bf16_t* Z = (const bf16_t*)(big + B_Z); bf16_t* Y = (bf16_t*)(big + B_Y); const float* gn = pp->in[17];
            const bf16_t* Y1a = (const bf16_t*)(big + B_Y1A); const bf16_t* Y1b = (const bf16_t*)(ws + WS_VT); const int Mhh = Mh >> 1;
            for (int lrb = gw; lrb < Mh; lrb += 2 * NGW) { u32x4 yv[2][4], zv[2][4], y1v[2][4];
#pragma unroll
                for (int q = 0; q < 2; ++q) { const int lr = min(lrb + q * NGW, Mh - 1);
#pragma unroll
                    for (int gI = 0; gI < 4; ++gI) { const int col = gI * 512 + lane * 8; yv[q][gI] = *(const u32x4*)(Y + (size_t)lr * 2048 + col); zv[q][gI] = *(const u32x4*)(Z + (size_t)lr * 2048 + col);
                        y1v[q][gI] = *(const u32x4*)((lr < Mhh ? Y1a + (size_t)lr * 2048 : Y1b + (size_t)(lr - Mhh) * 2048) + col); } }
#pragma unroll
                for (int q = 0; q < 2; ++q) { const int lr = lrb + q * NGW; if (lr < Mh) {
#pragma unroll
                    for (int gI = 0; gI < 4; ++gI) { const int col = gI * 512 + lane * 8;
                        float v[8]; float ss = 0.f;
#pragma unroll
                        for (int e = 0; e < 4; ++e) { v[2 * e] = (bflo(yv[q][gI][e]) + bflo(y1v[q][gI][e])) * silu_f(bflo(zv[q][gI][e])); v[2 * e + 1] = (bfhi(yv[q][gI][e]) + bfhi(y1v[q][gI][e])) * silu_f(bfhi(zv[q][gI][e])); ss += v[2 * e] * v[2 * e] + v[2 * e + 1] * v[2 * e + 1]; }
                        const float rr = __builtin_amdgcn_rsqf(wave_sum(ss) * (1.f / 512.f) + EPS);
                        const f32x4 g0 = *(const f32x4*)(gn + col), g1 = *(const f32x4*)(gn + col + 4);
                        u32x4 o; o.x = pk2(v[0] * rr * g0[0], v[1] * rr * g0[1]); o.y = pk2(v[2] * rr * g0[2], v[3] * rr * g0[3]); o.z = pk2(v[4] * rr * g1[0], v[5] * rr * g1[1]); o.w = pk2(v[6] * rr * g1[2], v[7] * rr * g1[3]);
                        *(u32x4*)(Y + (size_t)lr * 2048 + col) = o; } } } }
        } else if (k == 4 && PHM(4)) { asm volatile("; ==PHASE 4");
            pg8::Gemm g{(const bf16_t*)(big + B_Y), WT_out, 16384, 1024, 2048, 2048, 2048, 0, 0, 0}; S.init(16384, 1024, G, bx);
            EpiBf16 E{(bf16_t*)(big + B_MIX0), 1024, nullptr, nullptr, m0}; pg8::gemm_phase<EpiBf16>(lds, g, S, E, tid);
        } else if ((k == 5 || k == 9 || k == 17 || k == 21) && PHM(5)) { asm volatile("; ==PHASE 5");
            const bf16_t* mix = (const bf16_t*)(big + (k == 5 ? B_MIX0 : (k == 17 ? B_MIX1 : B_F)));
            const float* part = (const float*)(big + (k == 5 ? B_PART0 : (k == 17 ? B_PART2 : B_PART1)));
            const float* gpost = k == 5 ? pp->in[8] : (k == 9 ? pp->in[10] : (k == 17 ? pp->in[8] + 1024 : pp->in[10] + 1024));
            const float* g1 = k == 5 ? pp->in[9] : (k == 9 ? pp->in[7] + 1024 : (k == 17 ? pp->in[9] + 1024 : nullptr));
            const float* g2 = nullptr; const bool plain = k == 9;
            bf16_t* XNKV = (bf16_t*)(big + B_XNKV);
            for (int lrb = gw; lrb < Mh; lrb += 4 * NGW) {
                f32x4 mv[4][4], xv[4][4];
#pragma unroll
                for (int q = 0; q < 4; ++q) { const int lr = min(lrb + q * NGW, Mh - 1), r = m0 + lr;
                    const float* xi = k == 5 ? (r < NPROMPT_ROWS ? pp->in[0] + (size_t)r * 1024 : pp->in[1] + (size_t)(r - NPROMPT_ROWS) * 1024) : out + O_Y + (size_t)r * 1024;
#pragma unroll
                    for (int j = 0; j < 4; ++j) xv[q][j] = ((const f32x4*)xi)[lane + 64 * j];
                    if (pass && lr >= 16384) { const float* pr = part + (size_t)(lr - 16384) * 1024;
#pragma unroll
                        for (int j = 0; j < 4; ++j) mv[q][j] = ((const f32x4*)pr)[lane + 64 * j] + ((const f32x4*)(pr + (size_t)2048 * 1024))[lane + 64 * j];
                        if (k == 5 || k == 17) {
#pragma unroll
                            for (int j = 0; j < 4; ++j) mv[q][j] = mv[q][j] + (((const f32x4*)(pr + (size_t)2 * 2048 * 1024))[lane + 64 * j] + ((const f32x4*)(pr + (size_t)3 * 2048 * 1024))[lane + 64 * j]); } }
                    else {
#pragma unroll
                        for (int j = 0; j < 4; ++j) { const u32x2 mw = ((const u32x2*)(mix + (size_t)lr * 1024))[lane + 64 * j]; mv[q][j] = (f32x4){bflo(mw.x), bfhi(mw.x), bflo(mw.y), bfhi(mw.y)}; } } }
#pragma unroll
                for (int q = 0; q < 4; ++q) { const int lr = lrb + q * NGW; if (lr < Mh) { const int r = m0 + lr; float ss = 0.f;
#pragma unroll
                    for (int j = 0; j < 4; ++j) ss += mv[q][j][0] * mv[q][j][0] + mv[q][j][1] * mv[q][j][1] + mv[q][j][2] * mv[q][j][2] + mv[q][j][3] * mv[q][j][3];
                    const float rr = __builtin_amdgcn_rsqf(wave_sum(ss) * (1.f / 1024.f) + EPS); float s2 = 0.f;
#pragma unroll
                    for (int j = 0; j < 4; ++j) { const f32x4 gg = ((const f32x4*)gpost)[lane + 64 * j]; xv[q][j] = xv[q][j] + mv[q][j] * rr * gg; ((f32x4*)(out + O_Y + (size_t)r * 1024))[lane + 64 * j] = xv[q][j];
                        s2 += xv[q][j][0] * xv[q][j][0] + xv[q][j][1] * xv[q][j][1] + xv[q][j][2] * xv[q][j][2] + xv[q][j][3] * xv[q][j][3]; }
                    if (g1) { const float r2 = __builtin_amdgcn_rsqf(wave_sum(s2) * (1.f / 1024.f) + EPS);
#pragma unroll
                        for (int j = 0; j < 4; ++j) { const f32x4 gg = plain ? (f32x4){1.f, 1.f, 1.f, 1.f} : ((const f32x4*)g1)[lane + 64 * j]; u32x2 o; o.x = pk2(xv[q][j][0] * r2 * gg[0], xv[q][j][1] * r2 * gg[1]); o.y = pk2(xv[q][j][2] * r2 * gg[2], xv[q][j][3] * r2 * gg[3]);
                            ((u32x2*)(XN + (size_t)lr * 1024))[lane + 64 * j] = o;
                            if (g2) { const f32x4 g3 = ((const f32x4*)g2)[lane + 64 * j]; u32x2 o2; o2.x = pk2(xv[q][j][0] * r2 * g3[0], xv[q][j][1] * r2 * g3[1]); o2.y = pk2(xv[q][j][2] * r2 * g3[2], xv[q][j][3] * r2 * g3[3]);
                                ((u32x2*)(XNKV + (size_t)lr * 1024))[lane + 64 * j] = o2; } } } } }
            }
        } else if ((k == 6 || k == 18) && PHM(6)) { asm volatile("; ==PHASE 6");
            const int layer = k == 6 ? 0 : 1;
            pg8::Gemm g{XN, WT_up + (size_t)layer * 5632 * 1024, Mh, 5632, 1024, 1024, 1024, 0, 0, 0}; S.init(Mh, 5632, G, bx);
            EpiBf16 E{(bf16_t*)(big + B_U), 5632, out + O_PFFN + (size_t)layer * 16 * 2 * D_FF2, out + O_SFFN + (size_t)layer * 32 * 2 * D_FF2, m0};
            pg8::gemm_phase<EpiBf16>(lds, g, S, E, tid);
        } else if ((k == 7 || k == 19) && PHM(7)) { asm volatile("; ==PHASE 7");
            const int layer = k == 7 ? 0 : 1;
            const bf16_t* U = (const bf16_t*)(big + B_U); bf16_t* ACT = (bf16_t*)(big + B_ACT);
            const float* cwt = pp->in[30] + (size_t)layer * 3 * D_FF2; const float* cbs = pp->in[31] + (size_t)layer * D_FF2; const float* stf = pp->in[4] + (size_t)layer * 32 * 2 * D_FF2;
            const int nstrip = pass ? 512 + 256 : Mh / 32;
            for (int sp = bx; sp < nstrip; sp += G) { const int lr0 = sp < 512 ? sp * 32 : 16384 + (sp - 512) * 8; const int nr = sp < 512 ? 32 : 8; int seq, t0, T; row_decode(m0 + lr0, seq, t0, T);
                if (tid < 352) { const int j0 = tid * 8;
                    float wv[3][8], wg[3][8], bv[8], bg[8], p1v[8], p2v[8], p1g[8], p2g[8];
#pragma unroll
                    for (int i = 0; i < 3; ++i) { const f32x4 a0 = *(const f32x4*)(cwt + (size_t)i * D_FF2 + j0), a1 = *(const f32x4*)(cwt + (size_t)i * D_FF2 + j0 + 4), g0 = *(const f32x4*)(cwt + (size_t)i * D_FF2 + D_FF + j0), g1 = *(const f32x4*)(cwt + (size_t)i * D_FF2 + D_FF + j0 + 4);
#pragma unroll
                        for (int e = 0; e < 4; ++e) { wv[i][e] = a0[e]; wv[i][4 + e] = a1[e]; wg[i][e] = g0[e]; wg[i][4 + e] = g1[e]; } }
                    { const f32x4 b0 = *(const f32x4*)(cbs + j0), b1 = *(const f32x4*)(cbs + j0 + 4), b2 = *(const f32x4*)(cbs + D_FF + j0), b3 = *(const f32x4*)(cbs + D_FF + j0 + 4);
#pragma unroll
                      for (int e = 0; e < 4; ++e) { bv[e] = b0[e]; bv[4 + e] = b1[e]; bg[e] = b2[e]; bg[4 + e] = b3[e]; } }
                    if (t0 > 0) { const u32x4 a = *(const u32x4*)(U + (size_t)(lr0 - 2) * D_FF2 + j0), b = *(const u32x4*)(U + (size_t)(lr0 - 2) * D_FF2 + D_FF + j0), c = *(const u32x4*)(U + (size_t)(lr0 - 1) * D_FF2 + j0), d = *(const u32x4*)(U + (size_t)(lr0 - 1) * D_FF2 + D_FF + j0);
#pragma unroll
                        for (int e = 0; e < 4; ++e) { p2v[2 * e] = bflo(a[e]); p2v[2 * e + 1] = bfhi(a[e]); p2g[2 * e] = bflo(b[e]); p2g[2 * e + 1] = bfhi(b[e]); p1v[2 * e] = bflo(c[e]); p1v[2 * e + 1] = bfhi(c[e]); p1g[2 * e] = bflo(d[e]); p1g[2 * e + 1] = bfhi(d[e]); } }
                    else if (seq >= 16) { const float* s2 = stf + ((size_t)(seq - 16) * 2 + 0) * D_FF2 + j0; const float* s1 = s2 + D_FF2;
#pragma unroll
                        for (int e = 0; e < 8; ++e) { p2v[e] = s2[e]; p2g[e] = s2[D_FF + e]; p1v[e] = s1[e]; p1g[e] = s1[D_FF + e]; } }
                    else {
#pragma unroll
                        for (int e = 0; e < 8; ++e) { p2v[e] = 0.f; p2g[e] = 0.f; p1v[e] = 0.f; p1g[e] = 0.f; } }
#pragma unroll 8
                    for (int r = 0; r < nr; ++r) { const u32x4 a = *(const u32x4*)(U + (size_t)(lr0 + r) * D_FF2 + j0), b = *(const u32x4*)(U + (size_t)(lr0 + r) * D_FF2 + D_FF + j0);
                        float cv[8], cg[8], o[8];
#pragma unroll
                        for (int e = 0; e < 4; ++e) { cv[2 * e] = bflo(a[e]); cv[2 * e + 1] = bfhi(a[e]); cg[2 * e] = bflo(b[e]); cg[2 * e + 1] = bfhi(b[e]); }
#pragma unroll
                        for (int e = 0; e < 8; ++e) { const float va = bv[e] + wv[0][e] * p2v[e] + wv[1][e] * p1v[e] + wv[2][e] * cv[e]; const float ga = bg[e] + wg[0][e] * p2g[e] + wg[1][e] * p1g[e] + wg[2][e] * cg[e];
                            o[e] = gelu_tanh_f(ga) * va; p2v[e] = p1v[e]; p1v[e] = cv[e]; p2g[e] = p1g[e]; p1g[e] = cg[e]; }
                        u32x4 ov; ov.x = pk2(o[0], o[1]); ov.y = pk2(o[2], o[3]); ov.z = pk2(o[4], o[5]); ov.w = pk2(o[6], o[7]);
                        *(u32x4*)(ACT + (size_t)(lr0 + r) * D_FF + j0) = ov; }
                } }
        } else if ((k == 8 || k == 20) && PHM(8)) { asm volatile("; ==PHASE 8");
            const int layer = k == 8 ? 0 : 1;
            pg8::Gemm g{(const bf16_t*)(big + B_ACT), WT_down + (size_t)layer * 1024 * 2816, 16384, 1024, 2816, 2816, 2816, 0, 0, 0}; S.init(16384, 1024, G, bx);
            EpiBf16 E{(bf16_t*)(big + B_F), 1024, nullptr, nullptr, m0}; pg8::gemm_phase<EpiBf16>(lds, g, S, E, tid);
        } else if (k == 10 && PHM(10)) { asm volatile("; ==PHASE 10");
            { pg8::Gemm g{XN, WT_kv, Mh, 768, 1024, 1024, 1024, 0, 0, 0}; S.init(Mh, 768, G, bx); EpiF32 E{(float*)(big + B_KVRAW), 768}; pg8::gemm_phase<EpiF32>(lds, g, S, E, tid); }
        } else if (k == 11 && PHM(11)) { asm volatile("; ==PHASE 11");
            const float* KVRAW = (const float*)(big + B_KVRAW); const float* CQRAW = (const float*)(big + B_CQRAW); bf16_t* CQ = (bf16_t*)(big + B_CQ);
            LAS bf16_t* Tt = (LAS bf16_t*)lds;
            const int nchunk = Mh / 64;
            for (int ci = bx; ci < nchunk; ci += G) { int seq, t0, T; row_decode(m0 + ci * 64, seq, t0, T); const bool smp = seq >= 16;
                bf16_t* kcb; bf16_t* vtb; int Sk, key0;
                if (smp) { kcb = KCS + (size_t)(seq - 16) * 2112 * 320; vtb = VTS + (size_t)(seq - 16) * 256 * 2112; Sk = 2112; key0 = 2048 + t0; }
                else { const int sl = seq & 7; kcb = KC + (size_t)sl * 2048 * 320; vtb = VT + (size_t)sl * 256 * 2048; Sk = 2048; key0 = t0; }
                __syncthreads();
                for (int rr8 = 0; rr8 < 8; ++rr8) { const int li = wave * 8 + rr8, lr = ci * 64 + li, t = t0 + li; const int key = key0 + li;
                    const f32x4 v = *(const f32x4*)(KVRAW + (size_t)lr * 768 + lane * 4);
                    const float rr = __builtin_amdgcn_rsqf(wave_sum(v[0] * v[0] + v[1] * v[1] + v[2] * v[2] + v[3] * v[3]) * (1.f / 256.f) + EPS);
                    const f32x4 gg = *(const f32x4*)(pp->in[21] + lane * 4); const f32x4 cv = v * rr * gg;
                    float* lo = out + (smp ? O_SLAT + ((size_t)(seq - 16) * 64 + t) * 256 : O_PLAT + ((size_t)seq * 2048 + t) * 256);
                    *(f32x4*)(lo + lane * 4) = cv;
                    u32x2 o; o.x = pk2(cv[0], cv[1]); o.y = pk2(cv[2], cv[3]);
                    *(u32x2*)(kcb + (size_t)key * 320 + lane * 4) = o;
                    if (lane < 32) { const float x1 = KVRAW[(size_t)lr * 768 + 256 + lane], x2 = KVRAW[(size_t)lr * 768 + 288 + lane];
                        const float inv = __expf(-9.210340371976184f * (float)lane * (1.f / 32.f)); const float ang = (float)(smp ? 2048 + t : t) * inv; float sn, cs; sincos_rev(ang, sn, cs);
                        const float o1 = x1 * cs - x2 * sn, o2 = x2 * cs + x1 * sn;
                        float* ko = out + (smp ? O_SKPE + ((size_t)(seq - 16) * 64 + t) * 64 : O_PKPE + ((size_t)seq * 2048 + t) * 64);
                        ko[lane] = o1; ko[32 + lane] = o2;
                        kcb[(size_t)key * 320 + 256 + lane] = (bf16_t)f2bf(o1); kcb[(size_t)key * 320 + 288 + lane] = (bf16_t)f2bf(o2); } }
            }
            for (int lr = gw; lr < Mh; lr += NGW) { const f32x4 a = *(const f32x4*)(KVRAW + (size_t)lr * 768 + 320 + lane * 4); const f32x2 b = *(const f32x2*)(KVRAW + (size_t)lr * 768 + 576 + lane * 2);
                const float rr = __builtin_amdgcn_rsqf(wave_sum(a[0] * a[0] + a[1] * a[1] + a[2] * a[2] + a[3] * a[3] + b[0] * b[0] + b[1] * b[1]) * (1.f / 384.f) + EPS);
                const f32x4 ga = *(const f32x4*)(pp->in[26] + lane * 4); const f32x2 gb = *(const f32x2*)(pp->in[26] + 256 + lane * 2);
                u32x2 o; o.x = pk2(a[0] * rr * ga[0], a[1] * rr * ga[1]); o.y = pk2(a[2] * rr * ga[2], a[3] * rr * ga[3]);
                *(u32x2*)(CQ + (size_t)lr * 384 + lane * 4) = o; *(unsigned*)(CQ + (size_t)lr * 384 + 256 + lane * 2) = pk2(b[0] * rr * gb[0], b[1] * rr * gb[1]); }
        } else if (k == 12 && PHM(12)) { asm volatile("; ==PHASE 12");
            pg8::Gemm g{(const bf16_t*)(big + B_CQ), WT_uq, Mh, 3072, 384, 384, 384, 0, 0, 0}; S.init(Mh, 3072, G, bx);
            EpiUq E{(bf16_t*)(big + B_QNOPE), (bf16_t*)(big + B_QF)}; pg8::gemm_phase<EpiUq>(lds, g, S, E, tid);
        } else if (k == 13 && PHM(13)) { asm volatile("; ==PHASE 13");
            const float scale = 0.07216878364870322f * 1.4426950408889634f;
            { pg8::Gemm g{(const bf16_t*)(big + B_QNOPE), WUK, Mh, 4096, 128, 2048, 128, 128, 0, 0}; S.init(Mh, 4096, G, bx);
              EpiQlat E{(bf16_t*)(big + B_QF), scale}; pg8::gemm_phase<EpiQlat>(lds, g, S, E, tid); }
            bf16_t* QF = (bf16_t*)(big + B_QF);
            for (int lr = gw; lr < Mh; lr += NGW) { int seq, t, T; row_decode(m0 + lr, seq, t, T); const float pos = (float)(seq >= 16 ? 2048 + t : t);
                const int head = lane >> 2, i0 = (lane & 3) * 8; bf16_t* p = QF + (size_t)lr * 5120 + head * 320 + 256 + i0;
                const u32x4 a = *(const u32x4*)p, b = *(const u32x4*)(p + 32); float o1[8], o2[8];
#pragma unroll
                for (int e = 0; e < 8; ++e) { const float x1 = (e & 1) ? bfhi(a[e >> 1]) : bflo(a[e >> 1]), x2 = (e & 1) ? bfhi(b[e >> 1]) : bflo(b[e >> 1]);
                    const float inv = __expf(-9.210340371976184f * (float)(i0 + e) * (1.f / 32.f)); float sn, cs; sincos_rev(pos * inv, sn, cs);
                    o1[e] = (x1 * cs - x2 * sn) * scale; o2[e] = (x2 * cs + x1 * sn) * scale; }
                u32x4 w1, w2;
#pragma unroll
                for (int e = 0; e < 4; ++e) { w1[e] = pk2(o1[2 * e], o1[2 * e + 1]); w2[e] = pk2(o2[2 * e], o2[2 * e + 1]); }
                *(u32x4*)p = w1; *(u32x4*)(p + 32) = w2; }
        } else if (k == 14 && PHM(14)) { asm volatile("; ==PHASE 14");
            bf16_t* QF = (bf16_t*)(big + B_QF);
            typedef LAS bf16x4* trp_t; typedef float f32x16 __attribute__((ext_vector_type(16)));
            constexpr int KT = 41984, PB0 = 3 * KT, PSL = 4224, LSUM = PB0 + 8 * PSL;
            const bool swave = wave < 4; const int grp = wave & 3; const int c32 = lane & 31, h2 = lane >> 5;
            const int nsmp = pass ? 256 : 0, nunits = nsmp + 2048;
            const int wiq = G == 256 ? ((((bx >> 6) * 8 + (bx & 7)) << 3) | ((bx >> 3) & 7)) : bx;
#define ATT_STAGE(it_) do { if ((it_) + 1 < ntile) { LAS unsigned char* ktn = lds + (((it_) + 1) % 3) * KT; \
                _Pragma("unroll") for (int i = 0; i < 10; ++i) { *(LAS u32x4*)(ktn + sto + i * 16) = pk[i]; } \
                if ((it_) + 2 < ntile) { const int k0 = ((it_) + 2) * 64; \
                    _Pragma("unroll") for (int i = 0; i < 10; ++i) { pk[i] = *(const u32x4*)(kcb + (size_t)k0 * 320 + gto + i * 8); } } } } while (0)
            for (int un = wiq; un < nunits; un += G) {
                int row0, ntile; const bf16_t* kcb; int sub, hh;
                if (un < nsmp) { const int sb = un >> 3; sub = (un & 7) >> 1; hh = un & 1; row0 = NPROMPT_ROWS + sb * 64 + sub * 16; ntile = 33; kcb = KCS + (size_t)sb * 2112 * 320; }
                else { const int r0_ = un - nsmp; const int rnd = r0_ / G, wi = r0_ - rnd * G; const int r = ((rnd & 1) && (rnd + 1) * G <= 2048) ? rnd * G + (G - 1 - wi) : r0_;
                    const int qc = 31 - (r >> 6), rem = r & 63, sl = rem >> 3; sub = (rem & 7) >> 1; hh = rem & 1; const int seq = (pass ? 8 : 0) + sl;
                    row0 = seq * 2048 + qc * 64 + sub * 16; ntile = qc + 1; kcb = KC + (size_t)sl * 2048 * 320; }
                const int lrow0 = row0 - m0, head = hh * 8 + 2 * grp + (c32 >> 4);
                bf16_t* qrow = QF + (size_t)(lrow0 + (c32 & 15)) * 5120 + head * 320;
                __syncthreads();
                if (swave) { __builtin_amdgcn_s_setprio(3);
                    bf16x8 qf[20]; float mrun = -1e30f, lrun = 0.f;
                    u32x4 pk[10]; const int sto = ((tid >> 2) * 328 + (tid & 3) * 80) * 2, gto = (tid >> 2) * 320 + (tid & 3) * 80;
#pragma unroll
                    for (int i = 0; i < 10; ++i) { pk[i] = *(const u32x4*)(kcb + gto + i * 8); }
#pragma unroll
                    for (int ks = 0; ks < 20; ++ks) qf[ks] = *(const bf16x8*)(qrow + ks * 16 + h2 * 8);
#pragma unroll
                    for (int i = 0; i < 10; ++i) { *(LAS u32x4*)(lds + sto + i * 16) = pk[i]; }
                    { const int k1 = ntile > 1 ? 64 : 0;
#pragma unroll
                      for (int i = 0; i < 10; ++i) { pk[i] = *(const u32x4*)(kcb + (size_t)k1 * 320 + gto + i * 8); } }
                    __syncthreads();
                    for (int it = 0; it <= ntile; ++it) {
                        ATT_STAGE(it);
                        if (it < ntile) {
                            LAS unsigned char* kt = lds + (it % 3) * KT; LAS unsigned char* pb = lds + PB0 + ((it & 1) * 4 + grp) * PSL;
                            f32x16 sacc[2];
#pragma unroll
                            for (int kb = 0; kb < 2; ++kb)
#pragma unroll
                                for (int i = 0; i < 16; ++i) sacc[kb][i] = 0.f;
#pragma unroll
                            for (int ks = 0; ks < 20; ++ks) {
#pragma unroll
                                for (int kb = 0; kb < 2; ++kb) { const bf16x8 a = *(const LAS bf16x8*)(kt + ((kb * 32 + c32) * 328 + ks * 16 + h2 * 8) * 2); sacc[kb] = __builtin_amdgcn_mfma_f32_32x32x16_bf16(a, qf[ks], sacc[kb], 0, 0, 0); }
                            }
                            float mx = -1e30f;
#pragma unroll
                            for (int kb = 0; kb < 2; ++kb)
#pragma unroll
                                for (int i = 0; i < 16; ++i) mx = fmaxf(mx, sacc[kb][i]);
                            mx = fmaxf(mx, __shfl_xor(mx, 32));
                            const float mnew = fmaxf(mrun, mx), alpha = __builtin_amdgcn_exp2f(mrun - mnew); float rs = 0.f;
#pragma unroll
                            for (int kb = 0; kb < 2; ++kb)
#pragma unroll
                                for (int i = 0; i < 16; ++i) { sacc[kb][i] = __builtin_amdgcn_exp2f(sacc[kb][i] - mnew); rs += sacc[kb][i]; }
                            rs += __shfl_xor(rs, 32);
                            lrun = lrun * alpha + rs; mrun = mnew;
#pragma unroll
                            for (int kb = 0; kb < 2; ++kb)
#pragma unroll
                                for (int sp = 0; sp < 2; ++sp) { u32x4 pv; pv.x = pk2(sacc[kb][8 * sp + 0], sacc[kb][8 * sp + 1]); pv.y = pk2(sacc[kb][8 * sp + 2], sacc[kb][8 * sp + 3]); pv.z = pk2(sacc[kb][8 * sp + 4], sacc[kb][8 * sp + 5]); pv.w = pk2(sacc[kb][8 * sp + 6], sacc[kb][8 * sp + 7]);
                                    *(LAS u32x4*)(pb + (kb * 2 + sp) * 1024 + lane * 16) = pv; }
                            if (lane < 32) *(LAS float*)(pb + 4096 + lane * 4) = alpha;
                        }
                        __syncthreads();
                    }
                    if (lane < 32) *(LAS float*)(lds + LSUM + grp * 128 + lane * 4) = lrun;
                    __builtin_amdgcn_s_setprio(0);
                    __syncthreads();
                } else {
                    f32x16 oacc[8];
#pragma unroll
                    for (int rb = 0; rb < 8; ++rb)
#pragma unroll
                        for (int i = 0; i < 16; ++i) oacc[rb][i] = 0.f;
                    __syncthreads();
                    for (int it = 0; it <= ntile; ++it) {
                        if (it >= 1) {
                            LAS unsigned char* kt = lds + ((it - 1) % 3) * KT; LAS unsigned char* pb = lds + PB0 + (((it - 1) & 1) * 4 + grp) * PSL;
                            const float al = *(const LAS float*)(pb + 4096 + c32 * 4);
                            if (__any(al != 1.f)) {
#pragma unroll
                                for (int rb = 0; rb < 8; ++rb) oacc[rb] = oacc[rb] * al; }
                            LAS unsigned char* trb = kt + ((4 * h2 + ((lane & 15) >> 2)) * 328 + ((lane >> 4) & 1) * 16 + 4 * (lane & 3)) * 2;
#pragma unroll 2
                            for (int st = 0; st < 4; ++st) { const bf16x8 pv = *(const LAS bf16x8*)(pb + st * 1024 + lane * 16); LAS unsigned char* tr2 = trb + st * 16 * 656;
#pragma unroll
                                for (int rb = 0; rb < 8; ++rb) { const bf16x4 a0 = __builtin_amdgcn_ds_read_tr16_b64_v4i16((trp_t)(tr2 + rb * 64)), a1 = __builtin_amdgcn_ds_read_tr16_b64_v4i16((trp_t)(tr2 + 8 * 656 + rb * 64));
                                    const bf16x8 a = (bf16x8){a0[0], a0[1], a0[2], a0[3], a1[0], a1[1], a1[2], a1[3]};
                                    oacc[rb] = __builtin_amdgcn_mfma_f32_32x32x16_bf16(a, pv, oacc[rb], 0, 0, 0); } }
                        }
                        __syncthreads();
                    }
                    __syncthreads();
                    int ln2; asm volatile("v_mbcnt_lo_u32_b32 %0, -1, 0\n\tv_mbcnt_hi_u32_b32 %0, -1, %0" : "=v"(ln2));
                    const int c2 = ln2 & 31, hb = ln2 >> 5;
                    bf16_t* orow = QF + (size_t)(lrow0 + (c2 & 15)) * 5120 + (hh * 8 + 2 * grp + (c2 >> 4)) * 320;
                    const float inv = 1.f / *(const LAS float*)(lds + LSUM + grp * 128 + c2 * 4);
#pragma unroll
                    for (int rb = 0; rb < 8; ++rb)
#pragma unroll
                        for (int g4 = 0; g4 < 4; ++g4) { u32x2 o; o.x = pk2(oacc[rb][4 * g4 + 0] * inv, oacc[rb][4 * g4 + 1] * inv); o.y = pk2(oacc[rb][4 * g4 + 2] * inv, oacc[rb][4 * g4 + 3] * inv);
                            *(u32x2*)(orow + rb * 32 + 8 * g4 + 4 * hb) = o; }
                }
            }
#undef ATT_STAGE
        } else if (k == 15 && PHM(15)) { asm volatile("; ==PHASE 15");
            pg8::Gemm g{(const bf16_t*)(big + B_QF), WUV, Mh, 2048, 640, 5120, 640, 640, 0, 0}; S.init(Mh, 2048, G, bx);
            EpiBf16 E{(bf16_t*)(big + B_O2), 2048, nullptr, nullptr, m0}; pg8::gemm_phase<EpiBf16>(lds, g, S, E, tid);
        } else if (k == 16 && PHM(16)) { asm volatile("; ==PHASE 16");
            pg8::Gemm g{(const bf16_t*)(big + B_O2), WT_o, 16384, 1024, 2048, 2048, 2048, 0, 0, 0}; S.init(16384, 1024, G, bx);
            EpiBf16 E{(bf16_t*)(big + B_MIX1), 1024, nullptr, nullptr, m0}; pg8::gemm_phase<EpiBf16>(lds, g, S, E, tid);
        }
        if (pass && (k == 4 || k == 8 || k == 20 || k == 16)) {
            const bf16_t* A2; const bf16_t* B2; int ld2; float* part;
            if (k == 4) { A2 = (const bf16_t*)(big + B_Y); B2 = WT_out; ld2 = 2048; part = (float*)(big + B_PART0); }
            else if (k == 16) { A2 = (const bf16_t*)(big + B_O2); B2 = WT_o; ld2 = 2048; part = (float*)(big + B_PART2); }
            else { A2 = (const bf16_t*)(big + B_ACT); B2 = WT_down + (size_t)(k == 8 ? 0 : 1) * 1024 * 2816; ld2 = 2816; part = (float*)(big + B_PART1); }
            const int ns2 = (k == 4 || k == 16) ? 4 : 2, kp2 = ld2 / ns2;
            pg8::Gemm g{A2 + (size_t)16384 * ld2, B2, 2048, 1024 * ns2, kp2, ld2, ld2, 0, 4, kp2}; S.init(2048, 1024 * ns2, G, (bx + 96) % G);
            int lane2; asm volatile("v_mbcnt_lo_u32_b32 %0, -1, 0\n\tv_mbcnt_hi_u32_b32 %0, -1, %0" : "=v"(lane2));
            EpiF32Part E{part}; pg8::gemm_phase<EpiF32Part>(lds, g, S, E, wave_s * 64 + lane2);
        }
        if (ph + 1 < ph_hi) { XcdBarrier xb; xb.bar = (unsigned*)(ws + WS_CTL); xb.x = xb_xcc_id(); xb.st = (volatile LAS unsigned*)(lds + LDS_MISC); xcd_barrier(xb); }
    }
}

#ifndef MK_SINGLE
#define MK_SINGLE 1
#endif
extern "C" void kernel_launch(void* const* d_in, const int* in_sizes, int n_in, void* d_out, int out_size, void* d_ws, size_t ws_size, hipStream_t stream) {
    static int grid = 0;
    if (grid == 0) {
        if (n_in != 33 || ws_size < WS_CTL + CTL_BYTES) { fprintf(stderr, "kernel_launch: n_in %d ws %zu (need %zu)\n", n_in, ws_size, (size_t)WS_END); grid = -1; return; }
        int dev = 0, cus = 0, per_cu = 0;
        hipGetDevice(&dev); hipDeviceGetAttribute(&cus, hipDeviceAttributeMultiprocessorCount, dev);
        if (hipFuncSetAttribute((const void*)mk_fwd, hipFuncAttributeMaxDynamicSharedMemorySize, LDS_BYTES) != hipSuccess) { fprintf(stderr, "hipFuncSetAttribute failed\n"); grid = -1; return; }
        hipOccupancyMaxActiveBlocksPerMultiprocessor(&per_cu, (const void*)mk_fwd, 512, LDS_BYTES);
        if (per_cu < 1) { fprintf(stderr, "occupancy query says %d\n", per_cu); per_cu = 1; }
        (void)hipGetLastError();
        grid = cus * 1;
    }
    if (grid < 0) return;
    (void)hipMemsetAsync((char*)d_ws + WS_CTL, 0, CTL_BYTES, stream);
    Params p{};
    for (int i = 0; i < 33; ++i) p.in[i] = (const float*)d_in[i];
    p.out = (float*)d_out; p.ws = (unsigned char*)d_ws;
#if MK_SINGLE
    p.ph_lo = 0; p.ph_hi = 2 * (NPH + (DUP_PHASE >= 0 ? 1 : 0) + NULLPH);
    void* args[] = {&p};
    hipError_t e = hipLaunchCooperativeKernel((const void*)mk_fwd, dim3(grid), dim3(512), args, LDS_BYTES, stream);
    if (e != hipSuccess) fprintf(stderr, "cooperative launch failed: %s (grid %d)\n", hipGetErrorString(e), grid);
#else
    for (int ph = 0; ph < 2 * NPH; ++ph) { p.ph_lo = ph; p.ph_hi = ph + 1; hipLaunchKernelGGL(mk_fwd, dim3(grid), dim3(512), LDS_BYTES, stream, p); }
#endif
}
```

```cpp
#include <hip/hip_runtime.h>
#include <hip/hip_cooperative_groups.h>
#include <cstdio>
#include <cstdint>
namespace cg = cooperative_groups;

#define LAS __attribute__((address_space(3)))
typedef unsigned short bf16_t;
typedef short bf16x8 __attribute__((ext_vector_type(8)));
typedef short bf16x4 __attribute__((ext_vector_type(4)));
typedef float f32x4 __attribute__((ext_vector_type(4)));
typedef float f32x2 __attribute__((ext_vector_type(2)));
typedef unsigned u32x4 __attribute__((ext_vector_type(4)));
typedef unsigned u32x2 __attribute__((ext_vector_type(2)));

constexpr int D_MODEL = 1024, NPROMPT_ROWS = 32768, MTOT = 34816;
constexpr int D_INNER = 2048, CONV_DIM = 3072, D_FF = 2816, D_FF2 = 5632;
constexpr float EPS = 1e-6f;
constexpr int NPH = 23;
constexpr size_t O_Y = 0, O_PSSM = 35651584, O_PSSMCONV = 39845888, O_PFFN = 39993344, O_PLAT = 40353792, O_PKPE = 48742400,
                 O_SSSM = 50839552, O_SSSMCONV = 59228160, O_SFFN = 59523072, O_SLAT = 60243968, O_SKPE = 60768256;
constexpr size_t WS_WIN = 0;
constexpr size_t WS_WOUT = WS_WIN + 5376ull * 1024 * 2;
constexpr size_t WS_WUP = WS_WOUT + 1024ull * 2048 * 2;
constexpr size_t WS_WDOWN = WS_WUP + 2ull * 5632 * 1024 * 2;
constexpr size_t WS_WKV = WS_WDOWN + 2ull * 1024 * 2816 * 2;
constexpr size_t WS_WDQ = WS_WKV + 512ull * 1024 * 2;
constexpr size_t WS_WUQ = WS_WDQ + 512ull * 1024 * 2;
constexpr size_t WS_WUK = WS_WUQ + 3072ull * 384 * 2;
constexpr size_t WS_WUV = WS_WUK + 4096ull * 128 * 2;
constexpr size_t WS_WO = WS_WUV + 2048ull * 640 * 2;
constexpr size_t WS_XN = WS_WO + 1024ull * 2048 * 2;
constexpr size_t WS_KC = WS_XN + 18432ull * 1024 * 2;
constexpr size_t WS_VT = WS_KC + 83968ull * 320 * 2;
constexpr size_t WS_BIG = WS_VT + 83968ull * 256 * 2;
constexpr size_t BIG_BYTES = 323223552ull;
constexpr size_t WS_END = WS_BIG + BIG_BYTES;
constexpr size_t MiB = 1u << 20;
constexpr size_t B_Z = 0, B_XBC = 75497472, B_DTP = 188743680, B_Y = 75497472;
constexpr size_t B_Y1A = 150994944;
constexpr size_t B_XST = 191102976, B_BC = 266600448, B_BT = 285474816, B_CC = 304349184;
constexpr size_t B_MIX0 = 0;
constexpr size_t B_U = 0, B_ACT = 207618048, B_F = 0;
constexpr size_t B_XNKV = 207618048, B_KVRAW = 100 * MiB, B_CQRAW = 144 * MiB;
constexpr size_t B_PART0 = 191102976, B_PART1 = 100 * MiB, B_PART2 = 200 * MiB;
constexpr size_t B_CQ = 0, B_QNOPE = 16 * MiB, B_QF = 100 * MiB, B_O2 = 16 * MiB, B_MIX1 = 100 * MiB;

constexpr int LDS_BYTES = 163840;
#ifndef PHASE_MASK
#define PHASE_MASK 0xFFFFFFFFu
#endif
#define PHM(x) (((PHASE_MASK) >> (x)) & 1u)

__device__ __forceinline__ unsigned f2bf(float f) { unsigned u = __builtin_bit_cast(unsigned, f); return (u + 0x7fffu + ((u >> 16) & 1u)) >> 16; }
__device__ __forceinline__ unsigned pk2(float lo, float hi) { unsigned r; asm("v_cvt_pk_bf16_f32 %0, %1, %2" : "=v"(r) : "v"(lo), "v"(hi)); return r; }
__device__ __forceinline__ float bf2f(unsigned h) { return __builtin_bit_cast(float, h << 16); }
__device__ __forceinline__ float bflo(unsigned w) { return __builtin_bit_cast(float, w << 16); }
__device__ __forceinline__ float bfhi(unsigned w) { return __builtin_bit_cast(float, w & 0xffff0000u); }
__device__ __forceinline__ float wave_sum(float v) {
#pragma unroll
    for (int o = 1; o < 64; o <<= 1) v += __shfl_xor(v, o);
    return v;
}
__device__ __forceinline__ float silu_f(float v) { return v * __builtin_amdgcn_rcpf(1.f + __expf(-v)); }
__device__ __forceinline__ float gelu_tanh_f(float v) { const float u = 0.7978845608f * (v + 0.044715f * v * v * v); return v * __builtin_amdgcn_rcpf(1.f + __expf(-2.f * u)); }
__device__ __forceinline__ float softplus_f(float x) { return fmaxf(x, 0.f) + log1pf(__expf(-fabsf(x))); }
__device__ __forceinline__ void sincos_rev(float ang, float& s, float& c) { float f = ang * 0.15915494309f; f = f - floorf(f); s = __builtin_amdgcn_sinf(f); c = __builtin_amdgcn_cosf(f); }
__device__ __forceinline__ void row_decode(int r, int& seq, int& t, int& T) {
    if (r < NPROMPT_ROWS) { seq = r >> 11; t = r & 2047; T = 2048; } else { const int q = r - NPROMPT_ROWS; seq = 16 + (q >> 6); t = q & 63; T = 64; }
}

namespace pg8 {
constexpr int BM = 256, BK = 64, HALF = 128, HTB = HALF * BK * 2, STAGE_BYTES = 8 * HTB, NXCD = 8, WGM = 8;
__host__ __device__ __forceinline__ int lds_byte(int r, int c) { const int st = (r >> 4) * 2 + (c >> 5), rr = r & 15, cc = c & 31, ob = rr * 64 + cc * 2; return st * 1024 + (ob ^ (((ob >> 9) & 1) << 5)); }
__host__ __device__ __forceinline__ void stage_rc(int b, int& R, int& C) { const int st = b / 1024, sb = b % 1024, swz = sb ^ (((sb >> 9) & 1) << 5); R = (st >> 1) * 16 + swz / 64; C = (st & 1) * 32 + (swz % 64) / 2; }
__host__ __device__ __forceinline__ int perm32(int rho) { const int n = rho >> 4, i = rho & 15; return 8 * (i >> 2) + 4 * n + (i & 3); }
struct Unit { int pm, pn; };
struct Gemm { const bf16_t* A; const bf16_t* Bt; int M, N, K, lda, ldb, a_pn_step, ncol, kpart; };
struct StaticOrder {
    int nM, nN, nwg, G, c;
    __device__ void init(int M, int N, int G_, int c_) { nM = M / BM; nN = N / BM; nwg = nM * nN; G = G_; c = c_; }
    __device__ bool next(int i, Unit& u) const {
        const long L = (long)i * G + c; if (L >= nwg) return false;
        int wgid = (int)L; { const int q = nwg / NXCD, r = nwg % NXCD, xcd = wgid % NXCD, off = wgid / NXCD; wgid = (xcd < r ? xcd * (q + 1) : r * (q + 1) + (xcd - r) * q) + off; }
        const int nig = WGM * nN, gid = wgid / nig, fm = gid * WGM, gsz = (nM - fm) < WGM ? (nM - fm) : WGM;
        u.pm = fm + ((wgid % nig) % gsz); u.pn = (wgid % nig) / gsz; return true;
    }
};
template <class Epi>
__device__ __forceinline__ void gemm_phase(LAS unsigned char* lds, const Gemm g, const StaticOrder& S, const Epi& E, const int tid) {
    const int wid = __builtin_amdgcn_readfirstlane(tid >> 6), lane = tid & 63, wr = wid >> 2, wc = wid & 3, fr = lane & 15, fq = lane >> 4;
    int K = g.K; asm volatile("" : "+s"(K)); K = __builtin_amdgcn_readfirstlane(K); const int nt = K / BK;
    unsigned voffA[2], voffB[2];
#pragma unroll
    for (int i = 0; i < 2; ++i) { int R, C; stage_rc(tid * 16 + i * 8192, R, C); const int Rb = Epi::PERM ? ((R & ~31) + perm32(R & 31)) : R;
        voffA[i] = (unsigned)(R * g.lda + C) * 2u; voffB[i] = (unsigned)(Rb * g.ldb + C) * 2u; }
    const size_t kstep = (size_t)(BK * 2);
    const size_t hstepA = (size_t)HALF * g.lda * 2, hstepB = (size_t)HALF * g.ldb * 2;
    const size_t tstepA = 2 * hstepA, tstepB = 2 * hstepB, pnstepA = (size_t)g.a_pn_step * 2;
    const unsigned ldsw = (unsigned)wid * 1024u;
    const int aoff = lds_byte(wr * 64 + fr, fq * 8), boff = lds_byte(wc * 32 + fr, fq * 8);
#define PG8_SA(b, h) (((b) * 2 + (h)) * HTB)
#define PG8_SB(b, h) ((4 + (b) * 2 + (h)) * HTB)
#define PG8_STAGE(bufoff, gbase, voff) do { _Pragma("unroll") for (int _i = 0; _i < 2; ++_i) \
        __builtin_amdgcn_global_load_lds((const unsigned*)((const char*)(gbase) + (voff)[_i]), (LAS unsigned*)(lds + (bufoff) + ldsw + _i * 8192), 16, 0, 0); } while (0)
#define PG8_LDA(dst, b, h) do { _Pragma("unroll") for (int m = 0; m < 4; ++m) _Pragma("unroll") for (int k = 0; k < 2; ++k) dst[m][k] = *(const LAS bf16x8*)(lds + PG8_SA(b, h) + aoff + m * 2048 + k * 1024); } while (0)
#define PG8_LDB(dst, b, h) do { _Pragma("unroll") for (int n = 0; n < 2; ++n) _Pragma("unroll") for (int k = 0; k < 2; ++k) dst[n][k] = *(const LAS bf16x8*)(lds + PG8_SB(b, h) + boff + n * 2048 + k * 1024); } while (0)
#define PG8_MMA(ai, bj, At, Bt) do { __builtin_amdgcn_s_setprio(1); _Pragma("unroll") for (int m = 0; m < 4; ++m) _Pragma("unroll") for (int n = 0; n < 2; ++n) _Pragma("unroll") for (int k = 0; k < 2; ++k) \
        acc[ai][bj][m][n] = __builtin_amdgcn_mfma_f32_16x16x32_bf16(Bt[n][k], At[m][k], acc[ai][bj][m][n], 0, 0, 0); __builtin_amdgcn_s_setprio(0); } while (0)
#define PG8_WAIT_V(n) asm volatile("s_waitcnt vmcnt(" #n ")" ::: "memory")
#define PG8_WAIT_L(n) asm volatile("s_waitcnt lgkmcnt(" #n ")" ::: "memory")
#define PG8_BAR __builtin_amdgcn_s_barrier()
#define PG8_SCHED __builtin_amdgcn_sched_barrier(0)
    Unit cur, nxt; int ui = 0;
    if (!S.next(0, cur)) return;
    f32x4 acc[2][2][4][2];
#pragma unroll
    for (int a = 0; a < 2; ++a)
#pragma unroll
        for (int b = 0; b < 2; ++b)
#pragma unroll
            for (int m = 0; m < 4; ++m)
#pragma unroll
                for (int n = 0; n < 2; ++n) acc[a][b][m][n] = (f32x4){0.f, 0.f, 0.f, 0.f};
    bf16x8 At[4][2], B0[2][2], B1[2][2];
#define PG8_OFFA(u) (g.ncol ? (size_t)(u).pm * tstepA + (size_t)((u).pn / g.ncol) * (size_t)g.kpart * 2 : (size_t)(u).pm * tstepA + (size_t)(u).pn * pnstepA)
#define PG8_OFFB(u) (g.ncol ? (size_t)((u).pn % g.ncol) * tstepB + (size_t)((u).pn / g.ncol) * (size_t)g.kpart * 2 : (size_t)(u).pn * tstepB)
    const char* cA = (const char*)g.A + PG8_OFFA(cur); const char* cB = (const char*)g.Bt + PG8_OFFB(cur);
    PG8_STAGE(PG8_SB(0, 0), cB, voffB); PG8_STAGE(PG8_SB(0, 1), cB + hstepB, voffB); PG8_STAGE(PG8_SA(0, 0), cA, voffA); PG8_STAGE(PG8_SA(0, 1), cA + hstepA, voffA);
    if (wr == 1) PG8_BAR;
    PG8_WAIT_V(2); PG8_BAR;
    PG8_STAGE(PG8_SB(1, 0), cB + kstep, voffB); PG8_STAGE(PG8_SA(1, 0), cA + kstep, voffA); PG8_STAGE(PG8_SB(1, 1), cB + hstepB + kstep, voffB);
    PG8_WAIT_V(6); PG8_BAR;
    for (;;) {
        const bool has_next = S.next(ui + 1, nxt);
        const char* nA = has_next ? (const char*)g.A + PG8_OFFA(nxt) : cA; const char* nB = has_next ? (const char*)g.Bt + PG8_OFFB(nxt) : cB;
        for (int t = 0; t < nt; t += 2) {
            const bool last = (t == nt - 2);
            const char* a1 = cA + (size_t)(t + 1) * kstep;
            const char* a2 = last ? nA : cA + (size_t)(t + 2) * kstep; const char* b2 = last ? nB : cB + (size_t)(t + 2) * kstep;
            const char* a3 = a2 + kstep; const char* b3 = b2 + kstep;
            PG8_LDB(B0, 0, 0); PG8_LDB(B1, 0, 1); PG8_SCHED; PG8_LDA(At, 0, 0); PG8_STAGE(PG8_SA(1, 1), a1 + hstepA, voffA);
            PG8_WAIT_V(8); PG8_WAIT_L(0); PG8_BAR; PG8_MMA(0, 0, At, B0); PG8_MMA(0, 1, At, B1); PG8_BAR; PG8_SCHED;
            PG8_LDA(At, 0, 1); PG8_STAGE(PG8_SB(0, 0), b2, voffB); PG8_STAGE(PG8_SB(0, 1), b2 + hstepB, voffB); PG8_STAGE(PG8_SA(0, 0), a2, voffA);
            PG8_WAIT_V(8); PG8_WAIT_L(0); PG8_BAR; PG8_MMA(1, 0, At, B0); PG8_MMA(1, 1, At, B1); PG8_BAR; PG8_SCHED;
            PG8_LDB(B0, 1, 0); PG8_LDB(B1, 1, 1); PG8_SCHED; PG8_LDA(At, 1, 0); PG8_STAGE(PG8_SA(0, 1), a2 + hstepA, voffA);
            PG8_WAIT_V(8); PG8_WAIT_L(0); PG8_BAR; PG8_MMA(0, 0, At, B0); PG8_MMA(0, 1, At, B1); PG8_BAR; PG8_SCHED;
            PG8_LDA(At, 1, 1); PG8_STAGE(PG8_SB(1, 0), b3, voffB); PG8_STAGE(PG8_SB(1, 1), b3 + hstepB, voffB); PG8_STAGE(PG8_SA(1, 0), a3, voffA);
            PG8_WAIT_V(8); PG8_WAIT_L(0); PG8_BAR; PG8_MMA(1, 0, At, B0); PG8_MMA(1, 1, At, B1); PG8_BAR; PG8_SCHED;
        }
        if (wr == 0) PG8_BAR;
        { int le; asm volatile("v_mbcnt_lo_u32_b32 %0, -1, 0\n\tv_mbcnt_hi_u32_b32 %0, -1, %0" : "=v"(le));
          E(acc, cur, wr, wc, le & 15, le >> 4); }
        if (!has_next) break;
#pragma unroll
        for (int a = 0; a < 2; ++a)
#pragma unroll
            for (int b = 0; b < 2; ++b)
#pragma unroll
                for (int m = 0; m < 4; ++m)
#pragma unroll
                    for (int n = 0; n < 2; ++n) acc[a][b][m][n] = (f32x4){0.f, 0.f, 0.f, 0.f};
        cur = nxt; cA = nA; cB = nB; ++ui;
        if (wr == 1) PG8_BAR;
    }
    PG8_WAIT_V(0);
    PG8_BAR;
#undef PG8_OFFA
#undef PG8_OFFB
#undef PG8_SA
#undef PG8_SB
#undef PG8_STAGE
#undef PG8_LDA
#undef PG8_LDB
#undef PG8_MMA
#undef PG8_WAIT_V
#undef PG8_WAIT_L
#undef PG8_BAR
#undef PG8_SCHED
}
}
using pg8::Unit;
typedef f32x4 Acc[2][2][4][2];

__device__ __forceinline__ u32x4 pack8(const f32x4 v0, const f32x4 v1) { u32x4 w; w.x = pk2(v0[0], v0[1]); w.y = pk2(v0[2], v0[3]); w.z = pk2(v1[0], v1[1]); w.w = pk2(v1[2], v1[3]); return w; }

struct EpiF32 { static constexpr bool PERM = false; float* O; int ldc;
    __device__ __forceinline__ void operator()(const Acc& acc, const Unit& u, int wr, int wc, int fr, int fq) const {
        const int row0 = u.pm * 256 + wr * 64 + fr, col0 = u.pn * 256 + wc * 32 + 4 * fq;
#pragma unroll
        for (int ai = 0; ai < 2; ++ai)
#pragma unroll
            for (int m = 0; m < 4; ++m) { float* rowp = O + (size_t)(row0 + ai * 128 + m * 16) * ldc + col0;
#pragma unroll
                for (int bj = 0; bj < 2; ++bj)
#pragma unroll
                    for (int n = 0; n < 2; ++n) *(f32x4*)(rowp + bj * 128 + n * 16) = acc[ai][bj][m][n]; }
    }
};
struct EpiF32Part { static constexpr bool PERM = false; float* O;
    __device__ __forceinline__ void operator()(const Acc& acc, const Unit& u, int wr, int wc, int fr, int fq) const {
        const int kp = u.pn >> 2, ct = u.pn & 3; const int row0 = u.pm * 256 + wr * 64 + fr, col0 = ct * 256 + wc * 32 + 4 * fq; float* base = O + (size_t)kp * 2048 * 1024;
#pragma unroll
        for (int ai = 0; ai < 2; ++ai)
#pragma unroll
            for (int m = 0; m < 4; ++m) { float* rowp = base + (size_t)(row0 + ai * 128 + m * 16) * 1024 + col0;
#pragma unroll
                for (int bj = 0; bj < 2; ++bj)
#pragma unroll
                    for (int n = 0; n < 2; ++n) *(f32x4*)(rowp + bj * 128 + n * 16) = acc[ai][bj][m][n]; }
    }
};
struct EpiBf16 { static constexpr bool PERM = true; bf16_t* O; int ldc; float* st_p; float* st_s; int m0;
    __device__ __forceinline__ void operator()(const Acc& acc, const Unit& u, int wr, int wc, int fr, int fq) const {
        const int row0 = u.pm * 256 + wr * 64 + fr, col0 = u.pn * 256 + wc * 32 + 8 * fq;
#pragma unroll
        for (int ai = 0; ai < 2; ++ai)
#pragma unroll
            for (int m = 0; m < 4; ++m) { const int lrow = row0 + ai * 128 + m * 16; bf16_t* rowp = O + (size_t)lrow * ldc + col0;
#pragma unroll
                for (int bj = 0; bj < 2; ++bj) *(u32x4*)(rowp + bj * 128) = pack8(acc[ai][bj][m][0], acc[ai][bj][m][1]);
                if (st_p) { int seq, t, T; row_decode(m0 + lrow, seq, t, T); const int idx = t - (T - 2);
                    if (idx >= 0) { float* o = (seq < 16 ? st_p + (size_t)(seq * 2 + idx) * D_FF2 : st_s + (size_t)((seq - 16) * 2 + idx) * D_FF2) + col0;
#pragma unroll
                        for (int bj = 0; bj < 2; ++bj) { *(f32x4*)(o + bj * 128) = acc[ai][bj][m][0]; *(f32x4*)(o + bj * 128 + 4) = acc[ai][bj][m][1]; } } }
            }
    }
};
struct EpiInProj { static constexpr bool PERM = true; bf16_t* Z; bf16_t* XBC; float* DTP; const float* dt_bias; float* out; int m0;
    __device__ __forceinline__ void operator()(const Acc& acc, const Unit& u, int wr, int wc, int fr, int fq) const {
        const int row0 = u.pm * 256 + wr * 64 + fr;
        if (u.pn < 20) {
            bf16_t* base; int ld, colt; const bool isx = u.pn >= 8;
            if (!isx) { base = Z; ld = 2048; colt = u.pn * 256; } else { base = XBC; ld = 3072; colt = (u.pn - 8) * 256; }
            const int col0 = colt + wc * 32 + 8 * fq;
#pragma unroll
            for (int ai = 0; ai < 2; ++ai)
#pragma unroll
                for (int m = 0; m < 4; ++m) { const int lrow = row0 + ai * 128 + m * 16; bf16_t* rowp = base + (size_t)lrow * ld + col0;
#pragma unroll
                    for (int bj = 0; bj < 2; ++bj) *(u32x4*)(rowp + bj * 128) = pack8(acc[ai][bj][m][0], acc[ai][bj][m][1]);
                    if (isx) { int seq, t, T; row_decode(m0 + lrow, seq, t, T); const int idx = t - (T - 3);
                        if (idx >= 0) { float* o = out + (seq < 16 ? O_PSSMCONV + (size_t)(seq * 3 + idx) * CONV_DIM : O_SSSMCONV + (size_t)((seq - 16) * 3 + idx) * CONV_DIM) + col0;
#pragma unroll
                            for (int bj = 0; bj < 2; ++bj) { *(f32x4*)(o + bj * 128) = acc[ai][bj][m][0]; *(f32x4*)(o + bj * 128 + 4) = acc[ai][bj][m][1]; } } }
                }
        } else if (wc == 0) {
#pragma unroll
            for (int ai = 0; ai < 2; ++ai)
#pragma unroll
                for (int m = 0; m < 4; ++m) { const int lrow = row0 + ai * 128 + m * 16;
#pragma unroll
                    for (int n = 0; n < 2; ++n) { const int h0 = 8 * fq + 4 * n; f32x4 v = acc[ai][0][m][n]; f32x4 o;
#pragma unroll
                        for (int j = 0; j < 4; ++j) o[j] = softplus_f(v[j] + dt_bias[h0 + j]);
                        *(f32x4*)(DTP + (size_t)lrow * 32 + h0) = o; } }
        }
    }
};
struct EpiUq { static constexpr bool PERM = true; bf16_t* QN; bf16_t* QF;
    __device__ __forceinline__ void operator()(const Acc& acc, const Unit& u, int wr, int wc, int fr, int fq) const {
        const int row0 = u.pm * 256 + wr * 64 + fr;
#pragma unroll
        for (int bj = 0; bj < 2; ++bj) { bf16_t* dst; size_t ld;
            if (u.pn < 8) { dst = QN + u.pn * 256 + bj * 128 + wc * 32 + 8 * fq; ld = 2048; }
            else { const int c = (u.pn - 8) * 256 + bj * 128 + wc * 32 + 8 * fq; dst = QF + (c >> 6) * 320 + 256 + (c & 63); ld = 5120; }
#pragma unroll
            for (int ai = 0; ai < 2; ++ai)
#pragma unroll
                for (int m = 0; m < 4; ++m) { const int lrow = row0 + ai * 128 + m * 16; *(u32x4*)(dst + (size_t)lrow * ld) = pack8(acc[ai][bj][m][0], acc[ai][bj][m][1]); } }
    }
};
struct EpiQlat { static constexpr bool PERM = true; bf16_t* QF; float scale;
    __device__ __forceinline__ void operator()(const Acc& acc, const Unit& u, int wr, int wc, int fr, int fq) const {
        const int row0 = u.pm * 256 + wr * 64 + fr, col0 = u.pn * 320 + wc * 32 + 8 * fq;
#pragma unroll
        for (int ai = 0; ai < 2; ++ai)
#pragma unroll
            for (int m = 0; m < 4; ++m) { bf16_t* rowp = QF + (size_t)(row0 + ai * 128 + m * 16) * 5120 + col0;
#pragma unroll
                for (int bj = 0; bj < 2; ++bj) *(u32x4*)(rowp + bj * 128) = pack8(acc[ai][bj][m][0] * scale, acc[ai][bj][m][1] * scale); }
    }
};

struct Params { const float* in[33]; float* out; unsigned char* ws; int ph_lo, ph_hi; };

__device__ __forceinline__ void transpose_item(const float* W, int N, bf16_t* WT, int ldo, int row_off, LAS float* scr, int item, int lane, const float* gk = nullptr) {
    const int nblk = N / 32, kb = item / nblk, nb = item % nblk, k0 = 64 * kb, n0 = 32 * nb;
#pragma unroll 8
    for (int i = 0; i < 32; ++i) { const int kk = 2 * i + (lane >> 5); float w = W[(size_t)(k0 + kk) * N + n0 + (lane & 31)]; if (gk) w *= gk[k0 + kk]; scr[kk * 33 + (lane & 31)] = w; }
    asm volatile("s_waitcnt lgkmcnt(0)" ::: "memory");
    const int c = lane & 7;
#pragma unroll
    for (int j = 0; j < 4; ++j) { const int n = (lane >> 3) + 8 * j; const LAS float* s = scr + (8 * c) * 33 + n;
        u32x4 o; o.x = pk2(s[0 * 33], s[1 * 33]); o.y = pk2(s[2 * 33], s[3 * 33]); o.z = pk2(s[4 * 33], s[5 * 33]); o.w = pk2(s[6 * 33], s[7 * 33]);
        *(u32x4*)(WT + (size_t)(row_off + n0 + n) * ldo + k0 + 8 * c) = o; }
    asm volatile("s_waitcnt lgkmcnt(0)" ::: "memory");
}


#define XB_TMO      128
#define XB_XCNT(j)  (256  + 64 * (j))
#define XB_XSUB(j)  (1280 + 64 * (j))
#define XB_XGEN(j)  (2304 + 64 * (j))
#define XB_TOP      3328
#define XB_TOPGEN   3392
#define XCD_BAR_WORDS 3456
#define XB_SPIN_CAP (1u << 18)
__device__ __forceinline__ unsigned xb_ld(unsigned* p)              { return __hip_atomic_load(p, __ATOMIC_RELAXED, __HIP_MEMORY_SCOPE_AGENT); }
__device__ __forceinline__ unsigned xb_add(unsigned* p, unsigned v) { return __hip_atomic_fetch_add(p, v, __ATOMIC_RELAXED, __HIP_MEMORY_SCOPE_AGENT); }
__device__ __forceinline__ unsigned xb_xcc_id() { return (unsigned)__builtin_amdgcn_s_getreg((3 << 11) | 20) & 0xFu; }
#define XB_SPIN(cond, bar) do { unsigned _sp = 0; while (cond) { __builtin_amdgcn_s_sleep(1); \
    if ((++_sp & 255u) == 0u) { if (xb_ld(&(bar)[XB_TMO])) break; if (_sp > XB_SPIN_CAP) { atomicAdd(&(bar)[XB_TMO], 1u); break; } } } } while (0)
struct XcdBarrier { unsigned* bar; unsigned x; volatile LAS unsigned* st; };
__device__ __forceinline__ void xcd_barrier_complete(unsigned* bar, unsigned x, unsigned& nloc, unsigned& nx) {
    const unsigned G = gridDim.x * gridDim.y * gridDim.z;
    unsigned sum, cnt, mine, sp = 0u;
    for (;;) {
        sum = 0u; cnt = 0u; mine = 0u;
#pragma unroll
        for (unsigned j = 0; j < 16; ++j) { const unsigned c = xb_ld(&bar[XB_XCNT(j)]); sum += c; cnt += (c > 0u) ? 1u : 0u; mine = (j == x) ? c : mine; }
        if (sum == G) break;
        __builtin_amdgcn_s_sleep(1);
        if ((++sp & 255u) == 0u) { if (xb_ld(&bar[XB_TMO])) break; if (sp > XB_SPIN_CAP) { atomicAdd(&bar[XB_TMO], 1u); break; } }
    }
    nloc = mine > 0u ? mine : 1u; nx = cnt > 0u ? cnt : 1u;
}
__device__ __forceinline__ void xcd_barrier(const XcdBarrier& b) {
    asm volatile("s_waitcnt vmcnt(0)" ::: "memory");
    __syncthreads();
    if (threadIdx.x == 0) {
        unsigned* bar = b.bar;
        __builtin_amdgcn_s_waitcnt(0);
        unsigned nloc = b.st[0], nx = b.st[1];
        if (nloc == 0u) { xcd_barrier_complete(bar, b.x, nloc, nx); b.st[0] = nloc; b.st[1] = nx; }
        const unsigned old = xb_add(&bar[XB_XSUB(b.x)], 1u);
        const unsigned gen = old / nloc;
        if (old + 1u == (gen + 1u) * nloc) {
            __builtin_amdgcn_fence(__ATOMIC_RELEASE, "agent");
            asm volatile("s_waitcnt vmcnt(0)" ::: "memory");
            const unsigned og = xb_add(&bar[XB_TOP], 1u);
            const unsigned tg = og / nx;
            if (og + 1u == (tg + 1u) * nx) xb_add(&bar[XB_TOPGEN], 1u);
            else XB_SPIN(xb_ld(&bar[XB_TOPGEN]) == tg, bar);
            __builtin_amdgcn_fence(__ATOMIC_ACQUIRE, "agent");
            xb_add(&bar[XB_XGEN(b.x)], 1u);
            asm volatile("s_waitcnt vmcnt(0)" ::: "memory");
        } else {
            XB_SPIN(xb_ld(&bar[XB_XGEN(b.x)]) == gen, bar);
            __builtin_amdgcn_fence(__ATOMIC_ACQUIRE, "agent");
            asm volatile("s_waitcnt vmcnt(0)" ::: "memory");
        }
    }
    __syncthreads();
}
constexpr size_t WS_CTL = WS_END;
constexpr size_t CTL_BYTES = 16384;
constexpr int LDS_MISC = 163840 - 64;

__global__ void __launch_bounds__(512, 2) mk_fwd(Params P) {
    extern __shared__ __attribute__((aligned(16))) unsigned char lds_raw[];
    LAS unsigned char* lds = (LAS unsigned char*)lds_raw;
    cg::grid_group grid = cg::this_grid();
    const int ph_lo = P.ph_lo, ph_hi = P.ph_hi;
    if (threadIdx.x < 2) ((volatile LAS unsigned*)(lds + LDS_MISC))[threadIdx.x] = 0u;
    __syncthreads();
    if (threadIdx.x == 0) (void)xb_add((unsigned*)(P.ws + WS_CTL) + XB_XCNT(xb_xcc_id()), 1u);
    if (ph_hi == -12345) grid.sync();
    const int wave_s = __builtin_amdgcn_readfirstlane(threadIdx.x >> 6);
    for (int ph = ph_lo; ph < ph_hi; ++ph) {
        const __attribute__((address_space(4))) Params* pp; { unsigned long long v = (unsigned long long)__builtin_amdgcn_kernarg_segment_ptr(); asm volatile("" : "+s"(v));
            const unsigned lo = __builtin_amdgcn_readfirstlane((unsigned)v), hi = __builtin_amdgcn_readfirstlane((unsigned)(v >> 32)); pp = (const __attribute__((address_space(4))) Params*)(((unsigned long long)hi << 32) | lo); }
        int lane_o; asm volatile("v_mbcnt_lo_u32_b32 %0, -1, 0\n\tv_mbcnt_hi_u32_b32 %0, -1, %0" : "=v"(lane_o));
        const int tid = wave_s * 64 + lane_o;
        int bx = blockIdx.x; asm volatile("" : "+s"(bx)); bx = __builtin_amdgcn_readfirstlane(bx);
        int G = gridDim.x; asm volatile("" : "+s"(G)); G = __builtin_amdgcn_readfirstlane(G);
        unsigned char* ws = pp->ws;
        float* out = pp->out;
        const int lane = lane_o & 63, wave = wave_s;
        const int gw = bx * 8 + wave, NGW = G * 8;
        const int fr = lane & 15, fq = lane >> 4;
        bf16_t* WT_in = (bf16_t*)(ws + WS_WIN); bf16_t* WT_out = (bf16_t*)(ws + WS_WOUT); bf16_t* WT_up = (bf16_t*)(ws + WS_WUP); bf16_t* WT_down = (bf16_t*)(ws + WS_WDOWN);
        bf16_t* WT_kv = (bf16_t*)(ws + WS_WKV); bf16_t* WT_dq = (bf16_t*)(ws + WS_WDQ); bf16_t* WT_uq = (bf16_t*)(ws + WS_WUQ); bf16_t* WUK = (bf16_t*)(ws + WS_WUK);
        bf16_t* WUV = (bf16_t*)(ws + WS_WUV); bf16_t* WT_o = (bf16_t*)(ws + WS_WO);
        bf16_t* XN = (bf16_t*)(ws + WS_XN); bf16_t* KC = (bf16_t*)(ws + WS_KC); bf16_t* VT = (bf16_t*)(ws + WS_VT);
        unsigned char* big = ws + WS_BIG;
        bf16_t* KCS = KC + 8ull * 2048 * 320; bf16_t* VTS = VT + 8ull * 256 * 2048;
#ifndef DUP_PHASE
#define DUP_PHASE -1
#endif
#ifndef NULLPH
#define NULLPH 0
#endif
        constexpr int NPHQ = NPH + (DUP_PHASE >= 0 ? 1 : 0) + NULLPH;
        const int pass = ph / NPHQ; int kq = ph - pass * NPHQ;
        if (DUP_PHASE >= 0 && kq > DUP_PHASE) kq -= 1;
        const int k = kq >= NPH ? 999 : (kq <= 2 ? kq : (kq == 3 ? 100 : kq - 1));
        const int m0 = pass ? 16384 : 0, Mh = pass ? 18432 : 16384;
        pg8::StaticOrder S;
        if (k == 0 && PHM(0)) { asm volatile("; ==PHASE 0");
            LAS float* scr = (LAS float*)(lds + wave * 16384);
            if (pass == 0) {
                constexpr int I_IN = 16 * 161, I_OUT = 32 * 32, I_UP = 16 * 176, I_DOWN = 44 * 32, I_DKV = 16 * 8, I_KR = 16 * 2, I_DQ = 16 * 12, I_UQ = 6 * 96, I_O = 32 * 32;
                constexpr int NIT = I_IN + I_OUT + 2 * I_UP + 2 * I_DOWN + I_DKV + I_KR + I_DQ + I_UQ + I_O;
                for (int it = gw; it < NIT; it += NGW) {
                    int r = it;
                    if (r < I_IN) { transpose_item(pp->in[11], 5152, WT_in, 1024, 0, scr, r, lane); continue; } r -= I_IN;
                    if (r < I_OUT) { transpose_item(pp->in[18], 1024, WT_out, 2048, 0, scr, r, lane); continue; } r -= I_OUT;
                    if (r < I_UP) { transpose_item(pp->in[29], 5632, WT_up, 1024, 0, scr, r, lane); continue; } r -= I_UP;
                    if (r < I_UP) { transpose_item(pp->in[29] + 1024ull * 5632, 5632, WT_up + 5632ull * 1024, 1024, 0, scr, r, lane); continue; } r -= I_UP;
                    if (r < I_DOWN) { transpose_item(pp->in[32], 1024, WT_down, 2816, 0, scr, r, lane); continue; } r -= I_DOWN;
                    if (r < I_DOWN) { transpose_item(pp->in[32] + 2816ull * 1024, 1024, WT_down + 1024ull * 2816, 2816, 0, scr, r, lane); continue; } r -= I_DOWN;
                    if (r < I_DKV) { transpose_item(pp->in[20], 256, WT_kv, 1024, 0, scr, r, lane, pp->in[19]); continue; } r -= I_DKV;
                    if (r < I_KR) { transpose_item(pp->in[22], 64, WT_kv, 1024, 256, scr, r, lane, pp->in[19]); continue; } r -= I_KR;
                    if (r < I_DQ) { transpose_item(pp->in[25], 384, WT_kv, 1024, 320, scr, r, lane, pp->in[7] + 1024); continue; } r -= I_DQ;
                    if (r < I_UQ) { const int n0 = (r % 96) * 32, hh = n0 / 192, ww = n0 - hh * 192; const int dest = ww < 128 ? hh * 128 + ww : 2048 + hh * 64 + (ww - 128);
                        transpose_item(pp->in[27], 3072, WT_uq, 384, dest - n0, scr, r, lane); continue; } r -= I_UQ;
                    transpose_item(pp->in[28], 1024, WT_o, 2048, 0, scr, r, lane);
                }
                const size_t gt = (size_t)bx * 512 + tid, NT = (size_t)G * 512;
                for (size_t i = gt; i < 4096ull * 128; i += NT) { const int d = i & 127, n = (int)(i >> 7), h = n >> 8, r = n & 255; WUK[i] = (bf16_t)f2bf(pp->in[23][((size_t)r * 16 + h) * 128 + d]); }
                for (size_t i = gt; i < 2048ull * 640; i += NT) { const int kk = (int)(i % 640), n = (int)(i / 640), hp = n >> 8, j = (n >> 7) & 1, v = n & 127; const int r = kk - j * 320;
                    WUV[i] = (r >= 0 && r < 256) ? (bf16_t)f2bf(pp->in[24][((size_t)r * 16 + 2 * hp + j) * 128 + v]) : (bf16_t)0; }
            } else {
                const size_t gt = (size_t)bx * 512 + tid, NT = (size_t)G * 512;
                for (size_t i = gt; i < 32ull * 2048 * 40; i += NT) { const int cv = (int)(i % 40); const size_t rk = i / 40; const int sb = (int)(rk >> 11), key = (int)(rk & 2047);
                    const float* src = cv < 32 ? pp->in[5] + rk * 256 + cv * 8 : pp->in[6] + rk * 64 + (cv - 32) * 8;
                    const f32x4 a = *(const f32x4*)src, b = *(const f32x4*)(src + 4);
                    *(u32x4*)(KCS + ((size_t)sb * 2112 + key) * 320 + cv * 8) = pack8(a, b); }
            }
            const float* g = pp->in[7];
            for (int lrb = gw; lrb < Mh; lrb += 4 * NGW) { f32x4 v[4][4];
#pragma unroll
                for (int q = 0; q < 4; ++q) { const int lr = min(lrb + q * NGW, Mh - 1), r = m0 + lr; const float* xi = r < NPROMPT_ROWS ? pp->in[0] + (size_t)r * 1024 : pp->in[1] + (size_t)(r - NPROMPT_ROWS) * 1024;
#pragma unroll
                    for (int j = 0; j < 4; ++j) v[q][j] = ((const f32x4*)xi)[lane + 64 * j]; }
#pragma unroll
                for (int q = 0; q < 4; ++q) { const int lr = lrb + q * NGW; if (lr < Mh) { float ss = 0.f;
#pragma unroll
                    for (int j = 0; j < 4; ++j) ss += v[q][j][0] * v[q][j][0] + v[q][j][1] * v[q][j][1] + v[q][j][2] * v[q][j][2] + v[q][j][3] * v[q][j][3];
                    const float rr = __builtin_amdgcn_rsqf(wave_sum(ss) * (1.f / 1024.f) + EPS);
#pragma unroll
                    for (int j = 0; j < 4; ++j) { const f32x4 gg = ((const f32x4*)g)[lane + 64 * j]; u32x2 o; o.x = pk2(v[q][j][0] * rr * gg[0], v[q][j][1] * rr * gg[1]); o.y = pk2(v[q][j][2] * rr * gg[2], v[q][j][3] * rr * gg[3]);
                        ((u32x2*)(XN + (size_t)lr * 1024))[lane + 64 * j] = o; } } } }
        } else if (k == 1 && PHM(1)) { asm volatile("; ==PHASE 1");
            pg8::Gemm g{XN, WT_in, Mh, 5376, 1024, 1024, 1024, 0, 0, 0}; S.init(Mh, 5376, G, bx);
            EpiInProj E{(bf16_t*)(big + B_Z), (bf16_t*)(big + B_XBC), (float*)(big + B_DTP), pp->in[14], out, m0};
            pg8::gemm_phase<EpiInProj>(lds, g, S, E, tid);
        } else if (k == 2 && PHM(2)) { asm volatile("; ==PHASE 2");
            const bf16_t* XBC = (const bf16_t*)(big + B_XBC);
            bf16_t* XST = (bf16_t*)(big + B_XST); bf16_t* BC = (bf16_t*)(big + B_BC); bf16_t* BTg = (bf16_t*)(big + B_BT); bf16_t* CC = (bf16_t*)(big + B_CC);
            const float* cwg = pp->in[12]; const float* cbg = pp->in[13]; const float* stc = pp->in[3];
            LAS bf16_t* Tt = (LAS bf16_t*)lds;
            const int nun = (Mh / 64) * 48;
            const int l = tid >> 3, oc = tid & 7;
            for (int un0 = bx; un0 < nun; un0 += 3 * G) {
                u32x4 ov[3]; int cls[3], jbs[3];
                float rw[3][4][8];
#pragma unroll
                for (int q = 0; q < 3; ++q) { const int un = min(un0 + q * G, nun - 1); const int cl = un / 48, jb = un - cl * 48; const int c0 = jb * 64 + oc * 8; cls[q] = cl; jbs[q] = jb;
                    int seq, t0, T; row_decode(m0 + cl * 64, seq, t0, T);
#pragma unroll
                    for (int i = 0; i < 4; ++i) { const int t = t0 + l - 3 + i;
                        if (t >= 0) { const u32x4 w = *(const u32x4*)(XBC + (size_t)(cl * 64 + l - 3 + i) * CONV_DIM + c0);
#pragma unroll
                            for (int e = 0; e < 4; ++e) { rw[q][i][2 * e] = bflo(w[e]); rw[q][i][2 * e + 1] = bfhi(w[e]); } }
                        else if (seq >= 16) { const float* sp = stc + ((size_t)(seq - 16) * 3 + (3 + t)) * CONV_DIM + c0; const f32x4 a = *(const f32x4*)sp, b = *(const f32x4*)(sp + 4);
#pragma unroll
                            for (int e = 0; e < 4; ++e) { rw[q][i][e] = a[e]; rw[q][i][4 + e] = b[e]; } }
                        else {
#pragma unroll
                            for (int e = 0; e < 8; ++e) rw[q][i][e] = 0.f; } } }
#pragma unroll
                for (int q = 0; q < 3; ++q) { const int c0 = jbs[q] * 64 + oc * 8; float o[8];
                    { const f32x4 b0 = *(const f32x4*)(cbg + c0), b1 = *(const f32x4*)(cbg + c0 + 4);
#pragma unroll
                      for (int e = 0; e < 4; ++e) { o[e] = b0[e]; o[4 + e] = b1[e]; } }
#pragma unroll
                    for (int i = 0; i < 4; ++i) { const f32x4 w0 = *(const f32x4*)(cwg + (size_t)i * CONV_DIM + c0), w1 = *(const f32x4*)(cwg + (size_t)i * CONV_DIM + c0 + 4);
#pragma unroll
                        for (int e = 0; e < 4; ++e) { o[e] += w0[e] * rw[q][i][e]; o[4 + e] += w1[e] * rw[q][i][4 + e]; } }
#pragma unroll
                    for (int e = 0; e < 8; ++e) o[e] = silu_f(o[e]);
                    ov[q].x = pk2(o[0], o[1]); ov[q].y = pk2(o[2], o[3]); ov[q].z = pk2(o[4], o[5]); ov[q].w = pk2(o[6], o[7]); }
                __syncthreads();
#pragma unroll
                for (int q = 0; q < 3; ++q) { const bool valid = un0 + q * G < nun; const int cl = cls[q], jb = jbs[q];
                    if (valid && jb >= 40) *(u32x4*)(CC + (size_t)(cl * 64 + l) * 512 + (jb - 40) * 64 + oc * 8) = ov[q];
                    if (valid && jb >= 32 && jb < 40) *(u32x4*)(BC + (size_t)(cl * 64 + l) * 512 + (jb - 32) * 64 + oc * 8) = ov[q];
#pragma unroll
                    for (int e = 0; e < 4; ++e) { Tt[q * 4480 + (oc * 8 + 2 * e) * 70 + l] = (bf16_t)(ov[q][e] & 0xffff); Tt[q * 4480 + (oc * 8 + 2 * e + 1) * 70 + l] = (bf16_t)(ov[q][e] >> 16); } }
                __syncthreads();
#pragma unroll
                for (int q = 0; q < 3; ++q) { const bool valid = un0 + q * G < nun; const int cl = cls[q], jb = jbs[q];
                    if (valid && jb < 40) { const int c = tid >> 3, lv = tid & 7; u32x4 tv;
#pragma unroll
                        for (int e = 0; e < 4; ++e) tv[e] = *(const LAS unsigned*)(Tt + q * 4480 + c * 70 + lv * 8 + 2 * e);
                        bf16_t* d = jb < 32 ? XST + (((size_t)cl * 32 + jb) * 64 + c) * 64 + lv * 8 : BTg + (((size_t)cl * 4 + ((jb - 32) >> 1)) * 128 + ((jb - 32) & 1) * 64 + c) * 64 + lv * 8;
                        *(u32x4*)d = tv; } }
            }
        } else if (k == 100 && PHM(2)) { asm volatile("; ==PHASE 100");
            const int Hh = G >> 1;
            if (bx >= Hh) {
            const bf16_t* XST = (const bf16_t*)(big + B_XST); const bf16_t* BC = (const bf16_t*)(big + B_BC); const bf16_t* CC = (const bf16_t*)(big + B_CC);
            const float* DTP = (const float*)(big + B_DTP); bf16_t* Y1a = (bf16_t*)(big + B_Y1A); bf16_t* Y1b = (bf16_t*)(ws + WS_VT); const int Mhh = Mh >> 1;
            LAS bf16_t* Bm = (LAS bf16_t*)(lds);
            LAS bf16_t* Cm = (LAS bf16_t*)(lds + 17408);
            LAS bf16_t* xsT = (LAS bf16_t*)(lds + 34816);
            LAS float* sdt = (LAS float*)(lds + 108544);
            LAS float* sacs = sdt + 512;
            const int nun = (Mh / 64) * 4;
            for (int un = bx - Hh; un < nun; un += G - Hh) { const int cl = un >> 2, grp = un & 3; const int h = grp * 8 + wave;
                const float Ah = -__expf(pp->in[15][h]), Dh = pp->in[16][h];
                __syncthreads();
#pragma unroll
                for (int i = 0; i < 2; ++i) { const int v = tid + 512 * i, r = v >> 4, cv = v & 15; *(LAS u32x4*)(Bm + r * 136 + cv * 8) = *(const u32x4*)(BC + (size_t)(cl * 64 + r) * 512 + grp * 128 + cv * 8);
                    *(LAS u32x4*)(Cm + r * 136 + cv * 8) = *(const u32x4*)(CC + (size_t)(cl * 64 + r) * 512 + grp * 128 + cv * 8); }
#pragma unroll
                for (int i = 0; i < 8; ++i) { const int p = tid >> 3, lv = tid & 7; *(LAS u32x4*)(xsT + (i * 64 + p) * 72 + lv * 8) = *(const u32x4*)(XST + ((size_t)cl * 32 + grp * 8 + i) * 4096 + (size_t)tid * 8); }
                { const float dt = DTP[(size_t)(cl * 64 + lane) * 32 + h]; float a = dt * Ah;
#pragma unroll
                  for (int o = 1; o < 64; o <<= 1) { const float tv = __shfl_up(a, o); if (lane >= o) a += tv; }
                  sdt[wave * 64 + lane] = dt; sacs[wave * 64 + lane] = a; }
                __syncthreads();
                LAS const float* acs = sacs + wave * 64; LAS const float* dts = sdt + wave * 64; LAS const bf16_t* xh = xsT + wave * 64 * 72;
#pragma unroll
                for (int lb = 0; lb < 4; ++lb) { const int l_idx = lb * 16 + fr; const float acs_l = acs[l_idx];
                    f32x4 cb[4];
#pragma unroll
                    for (int sb = 0; sb < 4; ++sb) cb[sb] = (f32x4){0.f, 0.f, 0.f, 0.f};
#pragma unroll
                    for (int ks = 0; ks < 4; ++ks) { const bf16x8 bfr = *(const LAS bf16x8*)(Cm + l_idx * 136 + ks * 32 + fq * 8);
#pragma unroll
                        for (int sb = 0; sb < 4; ++sb) if (sb <= lb) { const bf16x8 afr = *(const LAS bf16x8*)(Bm + (sb * 16 + fr) * 136 + ks * 32 + fq * 8); cb[sb] = __builtin_amdgcn_mfma_f32_16x16x32_bf16(afr, bfr, cb[sb], 0, 0, 0); } }
                    bf16x8 wl[2];
#pragma unroll
                    for (int sb = 0; sb < 4; ++sb) { float wv[4];
#pragma unroll
                        for (int i = 0; i < 4; ++i) { const int sidx = sb * 16 + fq * 4 + i; wv[i] = (sb <= lb && sidx <= l_idx) ? cb[sb][i] * __expf(acs_l - acs[sidx]) * dts[sidx] : 0.f; }
                        const unsigned u0 = pk2(wv[0], wv[1]), u1 = pk2(wv[2], wv[3]); const int tt = sb >> 1, hf = sb & 1;
                        wl[tt][hf * 4 + 0] = (short)(u0 & 0xffff); wl[tt][hf * 4 + 1] = (short)(u0 >> 16); wl[tt][hf * 4 + 2] = (short)(u1 & 0xffff); wl[tt][hf * 4 + 3] = (short)(u1 >> 16); }
#pragma unroll
                    for (int pb = 0; pb < 4; ++pb) { f32x4 y = (f32x4){0.f, 0.f, 0.f, 0.f};
#pragma unroll
                        for (int tt = 0; tt < 2; ++tt) if (2 * tt <= lb) { const bf16x4 a0 = *(const LAS bf16x4*)(xh + (pb * 16 + fr) * 72 + 32 * tt + fq * 4), a1 = *(const LAS bf16x4*)(xh + (pb * 16 + fr) * 72 + 32 * tt + 16 + fq * 4);
                            const bf16x8 afr = (bf16x8){a0[0], a0[1], a0[2], a0[3], a1[0], a1[1], a1[2], a1[3]};
                            y = __builtin_amdgcn_mfma_f32_16x16x32_bf16(afr, wl[tt], y, 0, 0, 0); }
#pragma unroll
                        for (int i = 0; i < 4; ++i) y[i] += bf2f(xh[(pb * 16 + fq * 4 + i) * 72 + l_idx]) * Dh;
                        u32x2 o; o.x = pk2(y[0], y[1]); o.y = pk2(y[2], y[3]);
                        const int lr1 = cl * 64 + l_idx; bf16_t* y1 = lr1 < Mhh ? Y1a + (size_t)lr1 * D_INNER : Y1b + (size_t)(lr1 - Mhh) * D_INNER;
                        *(u32x2*)(y1 + h * 64 + pb * 16 + fq * 4) = o; } }
            }
            }
            {
            const bf16_t* XST = (const bf16_t*)(big + B_XST); const bf16_t* BTg = (const bf16_t*)(big + B_BT); const bf16_t* CC = (const bf16_t*)(big + B_CC);
            const float* DTP = (const float*)(big + B_DTP); bf16_t* Y = (bf16_t*)(big + B_Y);
            const int hl = wave >> 2, pq = wave & 3;
            const int nunits = pass ? 128 + 512 : 128;
            const int npr = bx < Hh ? (128 - bx + Hh - 1) / Hh : 0;
            for (int it = 0; ; ++it) { const int un = it < npr ? bx + it * Hh : 128 + bx + (it - npr) * G; if (un >= nunits) break;
                int seq, grp, hp;
                if (un < 128) { seq = (pass ? 8 : 0) + (un >> 4); grp = (un >> 2) & 3; hp = un & 3; } else { const int q = un - 128; seq = 16 + (q >> 4); grp = (q >> 2) & 3; hp = q & 3; }
                const bool smp = seq >= 16; const int nch = smp ? 1 : 32;
                const int lrow_base = (smp ? NPROMPT_ROWS + (seq - 16) * 64 : seq * 2048) - m0; const int cl_base = lrow_base >> 6;
                const int h = grp * 8 + hp * 2 + hl;
                const float Aw = -__expf(pp->in[15][grp * 8 + hp * 2 + (wave & 1)]);
                f32x4 st[8];
                { const float* sp = pp->in[2] + (((size_t)(smp ? seq - 16 : 0) * 32 + h) * 64 + pq * 16 + fr) * 128 + fq * 4;
#pragma unroll
                  for (int nb = 0; nb < 8; ++nb) { const f32x4 v = *(const f32x4*)(sp + nb * 16); st[nb] = smp ? v : (f32x4){0.f, 0.f, 0.f, 0.f}; } }
                u32x4 pf[6]; float pdt = 0.f; u32x2 yres[4];
#pragma unroll
                for (int lb = 0; lb < 4; ++lb) yres[lb] = (u32x2){0u, 0u};
#define SSD_PREFETCH(c_) do { const int c__ = (c_); const size_t rb_ = (size_t)(lrow_base + c__ * 64); \
                    _Pragma("unroll") for (int i = 0; i < 2; ++i) { const int v = tid + 512 * i, r = v >> 4, cv = v & 15; pf[i] = *(const u32x4*)(CC + (rb_ + r) * 512 + grp * 128 + cv * 8); \
                        pf[2 + i] = *(const u32x4*)(BTg + ((size_t)(cl_base + c__) * 4 + grp) * 8192 + (size_t)v * 8); \
                        pf[4 + i] = *(const u32x4*)(XST + ((size_t)(cl_base + c__) * 32 + grp * 8 + hp * 2 + i) * 4096 + (size_t)tid * 8); } \
                    if (wave < 2) pdt = DTP[(rb_ + lane) * 32 + grp * 8 + hp * 2 + wave]; } while (0)
#define SSD_WRITE(sg_) do { LAS unsigned char* sb_ = lds + (sg_) * 55296; LAS bf16_t* Cm_ = (LAS bf16_t*)sb_; LAS bf16_t* BT_ = (LAS bf16_t*)(sb_ + 17408); LAS bf16_t* xs_ = (LAS bf16_t*)(sb_ + 35840); LAS float* sa_ = (LAS float*)(sb_ + 54272); \
                    _Pragma("unroll") for (int i = 0; i < 2; ++i) { const int v = tid + 512 * i, r = v >> 4, cv = v & 15; *(LAS u32x4*)(Cm_ + r * 136 + cv * 8) = pf[i]; \
                        const int n = v >> 3, lv = v & 7; *(LAS u32x4*)(BT_ + n * 72 + lv * 8) = pf[2 + i]; \
                        const int p = tid >> 3, l8 = tid & 7; *(LAS u32x4*)(xs_ + (i * 64 + p) * 72 + l8 * 8) = pf[4 + i]; } \
                    if (wave < 2) { float a = pdt * Aw; \
                        _Pragma("unroll") for (int o = 1; o < 64; o <<= 1) { const float tv = __shfl_up(a, o); if (lane >= o) a += tv; } \
                        const float tot = __shfl(a, 63); \
                        sa_[wave * 64 + lane] = a; sa_[128 + wave * 64 + lane] = __expf(tot - a) * pdt; } } while (0)
                __syncthreads();
                SSD_PREFETCH(0);
                SSD_WRITE(0);
                SSD_PREFETCH((nch > 1 ? 1 : 0));
                __syncthreads();
                for (int c = 0; c < nch; ++c) {
                    if (c + 1 < nch) SSD_WRITE((c + 1) & 1);
                    if (c + 2 < nch) SSD_PREFETCH(c + 2);
                    if (c > 0) {
#pragma unroll
                        for (int lb = 0; lb < 4; ++lb) *(u32x2*)(Y + (size_t)(lrow_base + (c - 1) * 64 + lb * 16 + fr) * D_INNER + h * 64 + pq * 16 + fq * 4) = yres[lb]; }
                    LAS unsigned char* sbase = lds + (c & 1) * 55296;
                    LAS const bf16_t* Cm = (LAS const bf16_t*)sbase; LAS const bf16_t* BTl = (LAS const bf16_t*)(sbase + 17408); LAS const bf16_t* xsT = (LAS const bf16_t*)(sbase + 35840);
                    LAS const float* sacs = (LAS const float*)(sbase + 54272); LAS const float* sw = sacs + 128;
                    LAS const float* acs = sacs + hl * 64; LAS const float* sws = sw + hl * 64;
                    LAS const bf16_t* xh = xsT + hl * 64 * 72;
                    f32x4 ya[4];
#pragma unroll
                    for (int lb = 0; lb < 4; ++lb) ya[lb] = (f32x4){0.f, 0.f, 0.f, 0.f};
#pragma unroll
                    for (int tt = 0; tt < 4; ++tt) { const unsigned u0 = pk2(st[2 * tt][0], st[2 * tt][1]), u1 = pk2(st[2 * tt][2], st[2 * tt][3]), u2 = pk2(st[2 * tt + 1][0], st[2 * tt + 1][1]), u3 = pk2(st[2 * tt + 1][2], st[2 * tt + 1][3]);
                        const bf16x8 af = (bf16x8){(short)(u0 & 0xffff), (short)(u0 >> 16), (short)(u1 & 0xffff), (short)(u1 >> 16), (short)(u2 & 0xffff), (short)(u2 >> 16), (short)(u3 & 0xffff), (short)(u3 >> 16)};
#pragma unroll
                        for (int lb = 0; lb < 4; ++lb) { const bf16x4 b0 = *(const LAS bf16x4*)(Cm + (lb * 16 + fr) * 136 + 32 * tt + fq * 4), b1 = *(const LAS bf16x4*)(Cm + (lb * 16 + fr) * 136 + 32 * tt + 16 + fq * 4);
                            const bf16x8 bfr = (bf16x8){b0[0], b0[1], b0[2], b0[3], b1[0], b1[1], b1[2], b1[3]};
                            ya[lb] = __builtin_amdgcn_mfma_f32_16x16x32_bf16(af, bfr, ya[lb], 0, 0, 0); } }
#pragma unroll
                    for (int lb = 0; lb < 4; ++lb) { const float eal = __expf(acs[lb * 16 + fr]); const f32x4 y = ya[lb] * eal; u32x2 o;
                        o.x = pk2(y[0], y[1]); o.y = pk2(y[2], y[3]); yres[lb] = o; }
                    { const float dec = __expf(acs[63]);
#pragma unroll
                      for (int nb = 0; nb < 8; ++nb) st[nb] = st[nb] * dec;
#pragma unroll
                      for (int tt = 0; tt < 2; ++tt) { const f32x4 s0 = *(const LAS f32x4*)(sws + tt * 32 + fq * 8), s1 = *(const LAS f32x4*)(sws + tt * 32 + fq * 8 + 4);
                          const u32x4 xv = *(const LAS u32x4*)(xh + (pq * 16 + fr) * 72 + tt * 32 + fq * 8);
                          const unsigned u0 = pk2(bflo(xv[0]) * s0[0], bfhi(xv[0]) * s0[1]), u1 = pk2(bflo(xv[1]) * s0[2], bfhi(xv[1]) * s0[3]), u2 = pk2(bflo(xv[2]) * s1[0], bfhi(xv[2]) * s1[1]), u3 = pk2(bflo(xv[3]) * s1[2], bfhi(xv[3]) * s1[3]);
                          const bf16x8 xb = (bf16x8){(short)(u0 & 0xffff), (short)(u0 >> 16), (short)(u1 & 0xffff), (short)(u1 >> 16), (short)(u2 & 0xffff), (short)(u2 >> 16), (short)(u3 & 0xffff), (short)(u3 >> 16)};
#pragma unroll
                          for (int nb = 0; nb < 8; ++nb) { const bf16x8 afr = *(const LAS bf16x8*)(BTl + (nb * 16 + fr) * 72 + tt * 32 + fq * 8); st[nb] = __builtin_amdgcn_mfma_f32_16x16x32_bf16(afr, xb, st[nb], 0, 0, 0); } } }
                    __syncthreads();
                }
#undef SSD_WRITE
#undef SSD_PREFETCH
#pragma unroll
                for (int lb = 0; lb < 4; ++lb) *(u32x2*)(Y + (size_t)(lrow_base + (nch - 1) * 64 + lb * 16 + fr) * D_INNER + h * 64 + pq * 16 + fq * 4) = yres[lb];
                float* so = out + (smp ? O_SSSM + ((size_t)(seq - 16) * 32 + h) * 8192 : O_PSSM + ((size_t)seq * 32 + h) * 8192);
#pragma unroll
                for (int nb = 0; nb < 8; ++nb) *(f32x4*)(so + (pq * 16 + fr) * 128 + nb * 16 + fq * 4) = st[nb];
            }
            }
        } else if (k == 3 && PHM(3)) { asm volatile("; ==PHASE 3");
            const bf16_t* Z = (const bf16_t*)(big + B_Z); bf16_t* Y = (bf16_t*)(big + B_Y); const float* gn = pp->in[17];
            const bf16_t* Y1a = (const bf16_t*)(big + B_Y1A); const bf16_t* Y1b = (const bf16_t*)(ws + WS_VT); const int Mhh = Mh >> 1;
            for (int lrb = gw; lrb < Mh; lrb += 2 * NGW) { u32x4 yv[2][4], zv[2][4], y1v[2][4];
#pragma unroll
                for (int q = 0; q < 2; ++q) { const int lr = min(lrb + q * NGW, Mh - 1);
#pragma unroll
                    for (int gI = 0; gI < 4; ++gI) { const int col = gI * 512 + lane * 8; yv[q][gI] = *(const u32x4*)(Y + (size_t)lr * 2048 + col); zv[q][gI] = *(const u32x4*)(Z + (size_t)lr * 2048 + col);
                        y1v[q][gI] = *(const u32x4*)((lr < Mhh ? Y1a + (size_t)lr * 2048 : Y1b + (size_t)(lr - Mhh) * 2048) + col); } }
#pragma unroll
                for (int q = 0; q < 2; ++q) { const int lr = lrb + q * NGW; if (lr < Mh) {
#pragma unroll
                    for (int gI = 0; gI < 4; ++gI) { const int col = gI * 512 + lane * 8;
                        float v[8]; float ss = 0.f;
#pragma unroll
                        for (int e = 0; e < 4; ++e) { v[2 * e] = (bflo(yv[q][gI][e]) + bflo(y1v[q][gI][e])) * silu_f(bflo(zv[q][gI][e])); v[2 * e + 1] = (bfhi(yv[q][gI][e]) + bfhi(y1v[q][gI][e])) * silu_f(bfhi(zv[q][gI][e])); ss += v[2 * e] * v[2 * e] + v[2 * e + 1] * v[2 * e + 1]; }
                        const float rr = __builtin_amdgcn_rsqf(wave_sum(ss) * (1.f / 512.f) + EPS);
                        const f32x4 g0 = *(const f32x4*)(gn + col), g1 = *(const f32x4*)(gn + col + 4);
                        u32x4 o; o.x = pk2(v[0] * rr * g0[0], v[1] * rr * g0[1]); o.y = pk2(v[2] * rr * g0[2], v[3] * rr * g0[3]); o.z = pk2(v[4] * rr * g1[0], v[5] * rr * g1[1]); o.w = pk2(v[6] * rr * g1[2], v[7] * rr * g1[3]);
                        *(u32x4*)(Y + (size_t)lr * 2048 + col) = o; } } } }
        } else if (k == 4 && PHM(4)) { asm volatile("; ==PHASE 4");
            pg8::Gemm g{(const bf16_t*)(big + B_Y), WT_out, 16384, 1024, 2048, 2048, 2048, 0, 0, 0}; S.init(16384, 1024, G, bx);
            EpiBf16 E{(bf16_t*)(big + B_MIX0), 1024, nullptr, nullptr, m0}; pg8::gemm_phase<EpiBf16>(lds, g, S, E, tid);
        } else if ((k == 5 || k == 9 || k == 17 || k == 21) && PHM(5)) { asm volatile("; ==PHASE 5");
            const bf16_t* mix = (const bf16_t*)(big + (k == 5 ? B_MIX0 : (k == 17 ? B_MIX1 : B_F)));
            const float* part = (const float*)(big + (k == 5 ? B_PART0 : (k == 17 ? B_PART2 : B_PART1)));
            const float* gpost = k == 5 ? pp->in[8] : (k == 9 ? pp->in[10] : (k == 17 ? pp->in[8] + 1024 : pp->in[10] + 1024));
            const float* g1 = k == 5 ? pp->in[9] : (k == 9 ? pp->in[7] + 1024 : (k == 17 ? pp->in[9] + 1024 : nullptr));
            const float* g2 = nullptr; const bool plain = k == 9;
            bf16_t* XNKV = (bf16_t*)(big + B_XNKV);
            for (int lrb = gw; lrb < Mh; lrb += 4 * NGW) {
                f32x4 mv[4][4], xv[4][4];
#pragma unroll
                for (int q = 0; q < 4; ++q) { const int lr = min(lrb + q * NGW, Mh - 1), r = m0 + lr;
                    const float* xi = k == 5 ? (r < NPROMPT_ROWS ? pp->in[0] + (size_t)r * 1024 : pp->in[1] + (size_t)(r - NPROMPT_ROWS) * 1024) : out + O_Y + (size_t)r * 1024;
#pragma unroll
                    for (int j = 0; j < 4; ++j) xv[q][j] = ((const f32x4*)xi)[lane + 64 * j];
                    if (pass && lr >= 16384) { const float* pr = part + (size_t)(lr - 16384) * 1024;
#pragma unroll
                        for (int j = 0; j < 4; ++j) mv[q][j] = ((const f32x4*)pr)[lane + 64 * j] + ((const f32x4*)(pr + (size_t)2048 * 1024))[lane + 64 * j];
                        if (k == 5 || k == 17) {
#pragma unroll
                            for (int j = 0; j < 4; ++j) mv[q][j] = mv[q][j] + (((const f32x4*)(pr + (size_t)2 * 2048 * 1024))[lane + 64 * j] + ((const f32x4*)(pr + (size_t)3 * 2048 * 1024))[lane + 64 * j]); } }
                    else {
#pragma unroll
                        for (int j = 0; j < 4; ++j) { const u32x2 mw = ((const u32x2*)(mix + (size_t)lr * 1024))[lane + 64 * j]; mv[q][j] = (f32x4){bflo(mw.x), bfhi(mw.x), bflo(mw.y), bfhi(mw.y)}; } } }
#pragma unroll
                for (int q = 0; q < 4; ++q) { const int lr = lrb + q * NGW; if (lr < Mh) { const int r = m0 + lr; float ss = 0.f;
#pragma unroll
                    for (int j = 0; j < 4; ++j) ss += mv[q][j][0] * mv[q][j][0] + mv[q][j][1] * mv[q][j][1] + mv[q][j][2] * mv[q][j][2] + mv[q][j][3] * mv[q][j][3];
                    const float rr = __builtin_amdgcn_rsqf(wave_sum(ss) * (1.f / 1024.f) + EPS); float s2 = 0.f;
#pragma unroll
                    for (int j = 0; j < 4; ++j) { const f32x4 gg = ((const f32x4*)gpost)[lane + 64 * j]; xv[q][j] = xv[q][j] + mv[q][j] * rr * gg; ((f32x4*)(out + O_Y + (size_t)r * 1024))[lane + 64 * j] = xv[q][j];
                        s2 += xv[q][j][0] * xv[q][j][0] + xv[q][j][1] * xv[q][j][1] + xv[q][j][2] * xv[q][j][2] + xv[q][j][3] * xv[q][j][3]; }
                    if (g1) { const float r2 = __builtin_amdgcn_rsqf(wave_sum(s2) * (1.f / 1024.f) + EPS);
#pragma unroll
                        for (int j = 0; j < 4; ++j) { const f32x4 gg = plain ? (f32x4){1.f, 1.f, 1.f, 1.f} : ((const f32x4*)g1)[lane + 64 * j]; u32x2 o; o.x = pk2(xv[q][j][0] * r2 * gg[0], xv[q][j][1] * r2 * gg[1]); o.y = pk2(xv[q][j][2] * r2 * gg[2], xv[q][j][3] * r2 * gg[3]);
                            ((u32x2*)(XN + (size_t)lr * 1024))[lane + 64 * j] = o;
                            if (g2) { const f32x4 g3 = ((const f32x4*)g2)[lane + 64 * j]; u32x2 o2; o2.x = pk2(xv[q][j][0] * r2 * g3[0], xv[q][j][1] * r2 * g3[1]); o2.y = pk2(xv[q][j][2] * r2 * g3[2], xv[q][j][3] * r2 * g3[3]);
                                ((u32x2*)(XNKV + (size_t)lr * 1024))[lane + 64 * j] = o2; } } } } }
            }
        } else if ((k == 6 || k == 18) && PHM(6)) { asm volatile("; ==PHASE 6");
            const int layer = k == 6 ? 0 : 1;
            pg8::Gemm g{XN, WT_up + (size_t)layer * 5632 * 1024, Mh, 5632, 1024, 1024, 1024, 0, 0, 0}; S.init(Mh, 5632, G, bx);
            EpiBf16 E{(bf16_t*)(big + B_U), 5632, out + O_PFFN + (size_t)layer * 16 * 2 * D_FF2, out + O_SFFN + (size_t)layer * 32 * 2 * D_FF2, m0};
            pg8::gemm_phase<EpiBf16>(lds, g, S, E, tid);
        } else if ((k == 7 || k == 19) && PHM(7)) { asm volatile("; ==PHASE 7");
            const int layer = k == 7 ? 0 : 1;
            const bf16_t* U = (const bf16_t*)(big + B_U); bf16_t* ACT = (bf16_t*)(big + B_ACT);
            const float* cwt = pp->in[30] + (size_t)layer * 3 * D_FF2; const float* cbs = pp->in[31] + (size_t)layer * D_FF2; const float* stf = pp->in[4] + (size_t)layer * 32 * 2 * D_FF2;
            const int nstrip = pass ? 512 + 256 : Mh / 32;
            for (int sp = bx; sp < nstrip; sp += G) { const int lr0 = sp < 512 ? sp * 32 : 16384 + (sp - 512) * 8; const int nr = sp < 512 ? 32 : 8; int seq, t0, T; row_decode(m0 + lr0, seq, t0, T);
                if (tid < 352) { const int j0 = tid * 8;
                    float wv[3][8], wg[3][8], bv[8], bg[8], p1v[8], p2v[8], p1g[8], p2g[8];
#pragma unroll
                    for (int i = 0; i < 3; ++i) { const f32x4 a0 = *(const f32x4*)(cwt + (size_t)i * D_FF2 + j0), a1 = *(const f32x4*)(cwt + (size_t)i * D_FF2 + j0 + 4), g0 = *(const f32x4*)(cwt + (size_t)i * D_FF2 + D_FF + j0), g1 = *(const f32x4*)(cwt + (size_t)i * D_FF2 + D_FF + j0 + 4);
#pragma unroll
                        for (int e = 0; e < 4; ++e) { wv[i][e] = a0[e]; wv[i][4 + e] = a1[e]; wg[i][e] = g0[e]; wg[i][4 + e] = g1[e]; } }
                    { const f32x4 b0 = *(const f32x4*)(cbs + j0), b1 = *(const f32x4*)(cbs + j0 + 4), b2 = *(const f32x4*)(cbs + D_FF + j0), b3 = *(const f32x4*)(cbs + D_FF + j0 + 4);
#pragma unroll
                      for (int e = 0; e < 4; ++e) { bv[e] = b0[e]; bv[4 + e] = b1[e]; bg[e] = b2[e]; bg[4 + e] = b3[e]; } }
                    if (t0 > 0) { const u32x4 a = *(const u32x4*)(U + (size_t)(lr0 - 2) * D_FF2 + j0), b = *(const u32x4*)(U + (size_t)(lr0 - 2) * D_FF2 + D_FF + j0), c = *(const u32x4*)(U + (size_t)(lr0 - 1) * D_FF2 + j0), d = *(const u32x4*)(U + (size_t)(lr0 - 1) * D_FF2 + D_FF + j0);
#pragma unroll
                        for (int e = 0; e < 4; ++e) { p2v[2 * e] = bflo(a[e]); p2v[2 * e + 1] = bfhi(a[e]); p2g[2 * e] = bflo(b[e]); p2g[2 * e + 1] = bfhi(b[e]); p1v[2 * e] = bflo(c[e]); p1v[2 * e + 1] = bfhi(c[e]); p1g[2 * e] = bflo(d[e]); p1g[2 * e + 1] = bfhi(d[e]); } }
                    else if (seq >= 16) { const float* s2 = stf + ((size_t)(seq - 16) * 2 + 0) * D_FF2 + j0; const float* s1 = s2 + D_FF2;
#pragma unroll
                        for (int e = 0; e < 8; ++e) { p2v[e] = s2[e]; p2g[e] = s2[D_FF + e]; p1v[e] = s1[e]; p1g[e] = s1[D_FF + e]; } }
                    else {
#pragma unroll
                        for (int e = 0; e < 8; ++e) { p2v[e] = 0.f; p2g[e] = 0.f; p1v[e] = 0.f; p1g[e] = 0.f; } }
#pragma unroll 8
                    for (int r = 0; r < nr; ++r) { const u32x4 a = *(const u32x4*)(U + (size_t)(lr0 + r) * D_FF2 + j0), b = *(const u32x4*)(U + (size_t)(lr0 + r) * D_FF2 + D_FF + j0);
                        float cv[8], cg[8], o[8];
#pragma unroll
                        for (int e = 0; e < 4; ++e) { cv[2 * e] = bflo(a[e]); cv[2 * e + 1] = bfhi(a[e]); cg[2 * e] = bflo(b[e]); cg[2 * e + 1] = bfhi(b[e]); }
#pragma unroll
                        for (int e = 0; e < 8; ++e) { const float va = bv[e] + wv[0][e] * p2v[e] + wv[1][e] * p1v[e] + wv[2][e] * cv[e]; const float ga = bg[e] + wg[0][e] * p2g[e] + wg[1][e] * p1g[e] + wg[2][e] * cg[e];
                            o[e] = gelu_tanh_f(ga) * va; p2v[e] = p1v[e]; p1v[e] = cv[e]; p2g[e] = p1g[e]; p1g[e] = cg[e]; }
                        u32x4 ov; ov.x = pk2(o[0], o[1]); ov.y = pk2(o[2], o[3]); ov.z = pk2(o[4], o[5]); ov.w = pk2(o[6], o[7]);
                        *(u32x4*)(ACT + (size_t)(lr0 + r) * D_FF + j0) = ov; }
                } }
        } else if ((k == 8 || k == 20) && PHM(8)) { asm volatile("; ==PHASE 8");
            const int layer = k == 8 ? 0 : 1;
            pg8::Gemm g{(const bf16_t*)(big + B_ACT), WT_down + (size_t)layer * 1024 * 2816, 16384, 1024, 2816, 2816, 2816, 0, 0, 0}; S.init(16384, 1024, G, bx);
            EpiBf16 E{(bf16_t*)(big + B_F), 1024, nullptr, nullptr, m0}; pg8::gemm_phase<EpiBf16>(lds, g, S, E, tid);
        } else if (k == 10 && PHM(10)) { asm volatile("; ==PHASE 10");
            { pg8::Gemm g{XN, WT_kv, Mh, 768, 1024, 1024, 1024, 0, 0, 0}; S.init(Mh, 768, G, bx); EpiF32 E{(float*)(big + B_KVRAW), 768}; pg8::gemm_phase<EpiF32>(lds, g, S, E, tid); }
        } else if (k == 11 && PHM(11)) { asm volatile("; ==PHASE 11");
            const float* KVRAW = (const float*)(big + B_KVRAW); const float* CQRAW = (const float*)(big + B_CQRAW); bf16_t* CQ = (bf16_t*)(big + B_CQ);
            LAS bf16_t* Tt = (LAS bf16_t*)lds;
            const int nchunk = Mh / 64;
            for (int ci = bx; ci < nchunk; ci += G) { int seq, t0, T; row_decode(m0 + ci * 64, seq, t0, T); const bool smp = seq >= 16;
                bf16_t* kcb; bf16_t* vtb; int Sk, key0;
                if (smp) { kcb = KCS + (size_t)(seq - 16) * 2112 * 320; vtb = VTS + (size_t)(seq - 16) * 256 * 2112; Sk = 2112; key0 = 2048 + t0; }
                else { const int sl = seq & 7; kcb = KC + (size_t)sl * 2048 * 320; vtb = VT + (size_t)sl * 256 * 2048; Sk = 2048; key0 = t0; }
                __syncthreads();
                for (int rr8 = 0; rr8 < 8; ++rr8) { const int li = wave * 8 + rr8, lr = ci * 64 + li, t = t0 + li; const int key = key0 + li;
                    const f32x4 v = *(const f32x4*)(KVRAW + (size_t)lr * 768 + lane * 4);
                    const float rr = __builtin_amdgcn_rsqf(wave_sum(v[0] * v[0] + v[1] * v[1] + v[2] * v[2] + v[3] * v[3]) * (1.f / 256.f) + EPS);
                    const f32x4 gg = *(const f32x4*)(pp->in[21] + lane * 4); const f32x4 cv = v * rr * gg;
                    float* lo = out + (smp ? O_SLAT + ((size_t)(seq - 16) * 64 + t) * 256 : O_PLAT + ((size_t)seq * 2048 + t) * 256);
                    *(f32x4*)(lo + lane * 4) = cv;
                    u32x2 o; o.x = pk2(cv[0], cv[1]); o.y = pk2(cv[2], cv[3]);
                    *(u32x2*)(kcb + (size_t)key * 320 + lane * 4) = o;
                    if (lane < 32) { const float x1 = KVRAW[(size_t)lr * 768 + 256 + lane], x2 = KVRAW[(size_t)lr * 768 + 288 + lane];
                        const float inv = __expf(-9.210340371976184f * (float)lane * (1.f / 32.f)); const float ang = (float)(smp ? 2048 + t : t) * inv; float sn, cs; sincos_rev(ang, sn, cs);
                        const float o1 = x1 * cs - x2 * sn, o2 = x2 * cs + x1 * sn;
                        float* ko = out + (smp ? O_SKPE + ((size_t)(seq - 16) * 64 + t) * 64 : O_PKPE + ((size_t)seq * 2048 + t) * 64);
                        ko[lane] = o1; ko[32 + lane] = o2;
                        kcb[(size_t)key * 320 + 256 + lane] = (bf16_t)f2bf(o1); kcb[(size_t)key * 320 + 288 + lane] = (bf16_t)f2bf(o2); } }
            }
            for (int lr = gw; lr < Mh; lr += NGW) { const f32x4 a = *(const f32x4*)(KVRAW + (size_t)lr * 768 + 320 + lane * 4); const f32x2 b = *(const f32x2*)(KVRAW + (size_t)lr * 768 + 576 + lane * 2);
                const float rr = __builtin_amdgcn_rsqf(wave_sum(a[0] * a[0] + a[1] * a[1] + a[2] * a[2] + a[3] * a[3] + b[0] * b[0] + b[1] * b[1]) * (1.f / 384.f) + EPS);
                const f32x4 ga = *(const f32x4*)(pp->in[26] + lane * 4); const f32x2 gb = *(const f32x2*)(pp->in[26] + 256 + lane * 2);
                u32x2 o; o.x = pk2(a[0] * rr * ga[0], a[1] * rr * ga[1]); o.y = pk2(a[2] * rr * ga[2], a[3] * rr * ga[3]);
                *(u32x2*)(CQ + (size_t)lr * 384 + lane * 4) = o; *(unsigned*)(CQ + (size_t)lr * 384 + 256 + lane * 2) = pk2(b[0] * rr * gb[0], b[1] * rr * gb[1]); }
        } else if (k == 12 && PHM(12)) { asm volatile("; ==PHASE 12");
            pg8::Gemm g{(const bf16_t*)(big + B_CQ), WT_uq, Mh, 3072, 384, 384, 384, 0, 0, 0}; S.init(Mh, 3072, G, bx);
            EpiUq E{(bf16_t*)(big + B_QNOPE), (bf16_t*)(big + B_QF)}; pg8::gemm_phase<EpiUq>(lds, g, S, E, tid);
        } else if (k == 13 && PHM(13)) { asm volatile("; ==PHASE 13");
            const float scale = 0.07216878364870322f * 1.4426950408889634f;
            { pg8::Gemm g{(const bf16_t*)(big + B_QNOPE), WUK, Mh, 4096, 128, 2048, 128, 128, 0, 0}; S.init(Mh, 4096, G, bx);
              EpiQlat E{(bf16_t*)(big + B_QF), scale}; pg8::gemm_phase<EpiQlat>(lds, g, S, E, tid); }
            bf16_t* QF = (bf16_t*)(big + B_QF);
            for (int lr = gw; lr < Mh; lr += NGW) { int seq, t, T; row_decode(m0 + lr, seq, t, T); const float pos = (float)(seq >= 16 ? 2048 + t : t);
                const int head = lane >> 2, i0 = (lane & 3) * 8; bf16_t* p = QF + (size_t)lr * 5120 + head * 320 + 256 + i0;
                const u32x4 a = *(const u32x4*)p, b = *(const u32x4*)(p + 32); float o1[8], o2[8];
#pragma unroll
                for (int e = 0; e < 8; ++e) { const float x1 = (e & 1) ? bfhi(a[e >> 1]) : bflo(a[e >> 1]), x2 = (e & 1) ? bfhi(b[e >> 1]) : bflo(b[e >> 1]);
                    const float inv = __expf(-9.210340371976184f * (float)(i0 + e) * (1.f / 32.f)); float sn, cs; sincos_rev(pos * inv, sn, cs);
                    o1[e] = (x1 * cs - x2 * sn) * scale; o2[e] = (x2 * cs + x1 * sn) * scale; }
                u32x4 w1, w2;
#pragma unroll
                for (int e = 0; e < 4; ++e) { w1[e] = pk2(o1[2 * e], o1[2 * e + 1]); w2[e] = pk2(o2[2 * e], o2[2 * e + 1]); }
                *(u32x4*)p = w1; *(u32x4*)(p + 32) = w2; }
        } else if (k == 14 && PHM(14)) { asm volatile("; ==PHASE 14");
            bf16_t* QF = (bf16_t*)(big + B_QF);
            typedef LAS bf16x4* trp_t; typedef float f32x16 __attribute__((ext_vector_type(16)));
            constexpr int KT = 41984, PB0 = 3 * KT, PSL = 4224, LSUM = PB0 + 8 * PSL;
            const bool swave = wave < 4; const int grp = wave & 3; const int c32 = lane & 31, h2 = lane >> 5;
            const int nsmp = pass ? 256 : 0, nunits = nsmp + 2048;
            const int wiq = G == 256 ? ((((bx >> 6) * 8 + (bx & 7)) << 3) | ((bx >> 3) & 7)) : bx;
#define ATT_STAGE(it_) do { if ((it_) + 1 < ntile) { LAS unsigned char* ktn = lds + (((it_) + 1) % 3) * KT; \
                _Pragma("unroll") for (int i = 0; i < 10; ++i) { *(LAS u32x4*)(ktn + sto + i * 16) = pk[i]; } \
                if ((it_) + 2 < ntile) { const int k0 = ((it_) + 2) * 64; \
                    _Pragma("unroll") for (int i = 0; i < 10; ++i) { pk[i] = *(const u32x4*)(kcb + (size_t)k0 * 320 + gto + i * 8); } } } } while (0)
            for (int un = wiq; un < nunits; un += G) {
                int row0, ntile; const bf16_t* kcb; int sub, hh;
                if (un < nsmp) { const int sb = un >> 3; sub = (un & 7) >> 1; hh = un & 1; row0 = NPROMPT_ROWS + sb * 64 + sub * 16; ntile = 33; kcb = KCS + (size_t)sb * 2112 * 320; }
                else { const int r0_ = un - nsmp; const int rnd = r0_ / G, wi = r0_ - rnd * G; const int r = ((rnd & 1) && (rnd + 1) * G <= 2048) ? rnd * G + (G - 1 - wi) : r0_;
                    const int qc = 31 - (r >> 6), rem = r & 63, sl = rem >> 3; sub = (rem & 7) >> 1; hh = rem & 1; const int seq = (pass ? 8 : 0) + sl;
                    row0 = seq * 2048 + qc * 64 + sub * 16; ntile = qc + 1; kcb = KC + (size_t)sl * 2048 * 320; }
                const int lrow0 = row0 - m0, head = hh * 8 + 2 * grp + (c32 >> 4);
                bf16_t* qrow = QF + (size_t)(lrow0 + (c32 & 15)) * 5120 + head * 320;
                __syncthreads();
                if (swave) { __builtin_amdgcn_s_setprio(2);
                    bf16x8 qf[20]; float mrun = -1e30f, lrun = 0.f;
                    u32x4 pk[10]; const int sto = ((tid >> 2) * 328 + (tid & 3) * 80) * 2, gto = (tid >> 2) * 320 + (tid & 3) * 80;
#pragma unroll
                    for (int i = 0; i < 10; ++i) { pk[i] = *(const u32x4*)(kcb + gto + i * 8); }
#pragma unroll
                    for (int ks = 0; ks < 20; ++ks) qf[ks] = *(const bf16x8*)(qrow + ks * 16 + h2 * 8);
#pragma unroll
                    for (int i = 0; i < 10; ++i) { *(LAS u32x4*)(lds + sto + i * 16) = pk[i]; }
                    { const int k1 = ntile > 1 ? 64 : 0;
#pragma unroll
                      for (int i = 0; i < 10; ++i) { pk[i] = *(const u32x4*)(kcb + (size_t)k1 * 320 + gto + i * 8); } }
                    __syncthreads();
                    for (int it = 0; it <= ntile; ++it) {
                        ATT_STAGE(it);
                        if (it < ntile) {
                            LAS unsigned char* kt = lds + (it % 3) * KT; LAS unsigned char* pb = lds + PB0 + ((it & 1) * 4 + grp) * PSL;
                            f32x16 sacc[2];
#pragma unroll
                            for (int kb = 0; kb < 2; ++kb)
#pragma unroll
                                for (int i = 0; i < 16; ++i) sacc[kb][i] = 0.f;
#pragma unroll
                            for (int ks = 0; ks < 20; ++ks) {
#pragma unroll
                                for (int kb = 0; kb < 2; ++kb) { const bf16x8 a = *(const LAS bf16x8*)(kt + ((kb * 32 + c32) * 328 + ks * 16 + h2 * 8) * 2); sacc[kb] = __builtin_amdgcn_mfma_f32_32x32x16_bf16(a, qf[ks], sacc[kb], 0, 0, 0); }
                            }
                            float mx = -1e30f;
#pragma unroll
                            for (int kb = 0; kb < 2; ++kb)
#pragma unroll
                                for (int i = 0; i < 16; ++i) mx = fmaxf(mx, sacc[kb][i]);
                            mx = fmaxf(mx, __shfl_xor(mx, 32));
                            const float mnew = fmaxf(mrun, mx), alpha = __builtin_amdgcn_exp2f(mrun - mnew); float rs = 0.f;
#pragma unroll
                            for (int kb = 0; kb < 2; ++kb)
#pragma unroll
                                for (int i = 0; i < 16; ++i) { sacc[kb][i] = __builtin_amdgcn_exp2f(sacc[kb][i] - mnew); rs += sacc[kb][i]; }
                            rs += __shfl_xor(rs, 32);
                            lrun = lrun * alpha + rs; mrun = mnew;
#pragma unroll
                            for (int kb = 0; kb < 2; ++kb)
#pragma unroll
                                for (int sp = 0; sp < 2; ++sp) { u32x4 pv; pv.x = pk2(sacc[kb][8 * sp + 0], sacc[kb][8 * sp + 1]); pv.y = pk2(sacc[kb][8 * sp + 2], sacc[kb][8 * sp + 3]); pv.z = pk2(sacc[kb][8 * sp + 4], sacc[kb][8 * sp + 5]); pv.w = pk2(sacc[kb][8 * sp + 6], sacc[kb][8 * sp + 7]);
                                    *(LAS u32x4*)(pb + (kb * 2 + sp) * 1024 + lane * 16) = pv; }
                            if (lane < 32) *(LAS float*)(pb + 4096 + lane * 4) = alpha;
                        }
                        __syncthreads();
                    }
                    if (lane < 32) *(LAS float*)(lds + LSUM + grp * 128 + lane * 4) = lrun;
                    __builtin_amdgcn_s_setprio(0);
                    __syncthreads();
                } else {
                    f32x16 oacc[8];
#pragma unroll
                    for (int rb = 0; rb < 8; ++rb)
#pragma unroll
                        for (int i = 0; i < 16; ++i) oacc[rb][i] = 0.f;
                    __syncthreads();
                    for (int it = 0; it <= ntile; ++it) {
                        if (it >= 1) {
                            LAS unsigned char* kt = lds + ((it - 1) % 3) * KT; LAS unsigned char* pb = lds + PB0 + (((it - 1) & 1) * 4 + grp) * PSL;
                            const float al = *(const LAS float*)(pb + 4096 + c32 * 4);
                            if (__any(al != 1.f)) {
#pragma unroll
                                for (int rb = 0; rb < 8; ++rb) oacc[rb] = oacc[rb] * al; }
                            LAS unsigned char* trb = kt + ((4 * h2 + ((lane & 15) >> 2)) * 328 + ((lane >> 4) & 1) * 16 + 4 * (lane & 3)) * 2;
#pragma unroll 2
                            for (int st = 0; st < 4; ++st) { const bf16x8 pv = *(const LAS bf16x8*)(pb + st * 1024 + lane * 16); LAS unsigned char* tr2 = trb + st * 16 * 656;
#pragma unroll
                                for (int rb = 0; rb < 8; ++rb) { const bf16x4 a0 = __builtin_amdgcn_ds_read_tr16_b64_v4i16((trp_t)(tr2 + rb * 64)), a1 = __builtin_amdgcn_ds_read_tr16_b64_v4i16((trp_t)(tr2 + 8 * 656 + rb * 64));
                                    const bf16x8 a = (bf16x8){a0[0], a0[1], a0[2], a0[3], a1[0], a1[1], a1[2], a1[3]};
                                    oacc[rb] = __builtin_amdgcn_mfma_f32_32x32x16_bf16(a, pv, oacc[rb], 0, 0, 0); } }
                        }
                        __syncthreads();
                    }
                    __syncthreads();
                    int ln2; asm volatile("v_mbcnt_lo_u32_b32 %0, -1, 0\n\tv_mbcnt_hi_u32_b32 %0, -1, %0" : "=v"(ln2));
                    const int c2 = ln2 & 31, hb = ln2 >> 5;
                    bf16_t* orow = QF + (size_t)(lrow0 + (c2 & 15)) * 5120 + (hh * 8 + 2 * grp + (c2 >> 4)) * 320;
                    const float inv = 1.f / *(const LAS float*)(lds + LSUM + grp * 128 + c2 * 4);
#pragma unroll
                    for (int rb = 0; rb < 8; ++rb)
#pragma unroll
                        for (int g4 = 0; g4 < 4; ++g4) { u32x2 o; o.x = pk2(oacc[rb][4 * g4 + 0] * inv, oacc[rb][4 * g4 + 1] * inv); o.y = pk2(oacc[rb][4 * g4 + 2] * inv, oacc[rb][4 * g4 + 3] * inv);
                            *(u32x2*)(orow + rb * 32 + 8 * g4 + 4 * hb) = o; }
                }
            }
#undef ATT_STAGE
        } else if (k == 15 && PHM(15)) { asm volatile("; ==PHASE 15");
            pg8::Gemm g{(const bf16_t*)(big + B_QF), WUV, Mh, 2048, 640, 5120, 640, 640, 0, 0}; S.init(Mh, 2048, G, bx);
            EpiBf16 E{(bf16_t*)(big + B_O2), 2048, nullptr, nullptr, m0}; pg8::gemm_phase<EpiBf16>(lds, g, S, E, tid);
        } else if (k == 16 && PHM(16)) { asm volatile("; ==PHASE 16");
            pg8::Gemm g{(const bf16_t*)(big + B_O2), WT_o, 16384, 1024, 2048, 2048, 2048, 0, 0, 0}; S.init(16384, 1024, G, bx);
            EpiBf16 E{(bf16_t*)(big + B_MIX1), 1024, nullptr, nullptr, m0}; pg8::gemm_phase<EpiBf16>(lds, g, S, E, tid);
        }
        if (pass && (k == 4 || k == 8 || k == 20 || k == 16)) {
            const bf16_t* A2; const bf16_t* B2; int ld2; float* part;
            if (k == 4) { A2 = (const bf16_t*)(big + B_Y); B2 = WT_out; ld2 = 2048; part = (float*)(big + B_PART0); }
            else if (k == 16) { A2 = (const bf16_t*)(big + B_O2); B2 = WT_o; ld2 = 2048; part = (float*)(big + B_PART2); }
            else { A2 = (const bf16_t*)(big + B_ACT); B2 = WT_down + (size_t)(k == 8 ? 0 : 1) * 1024 * 2816; ld2 = 2816; part = (float*)(big + B_PART1); }
            const int ns2 = (k == 4 || k == 16) ? 4 : 2, kp2 = ld2 / ns2;
            pg8::Gemm g{A2 + (size_t)16384 * ld2, B2, 2048, 1024 * ns2, kp2, ld2, ld2, 0, 4, kp2}; S.init(2048, 1024 * ns2, G, (bx + 96) % G);
            int lane2; asm volatile("v_mbcnt_lo_u32_b32 %0, -1, 0\n\tv_mbcnt_hi_u32_b32 %0, -1, %0" : "=v"(lane2));
            EpiF32Part E{part}; pg8::gemm_phase<EpiF32Part>(lds, g, S, E, wave_s * 64 + lane2);
        }
        if (ph + 1 < ph_hi) { XcdBarrier xb; xb.bar = (unsigned*)(ws + WS_CTL); xb.x = xb_xcc_id(); xb.st = (volatile LAS unsigned*)(lds + LDS_MISC); xcd_barrier(xb); }
    }
}

#ifndef MK_SINGLE
#define MK_SINGLE 1
#endif
extern "C" void kernel_launch(void* const* d_in, const int* in_sizes, int n_in, void* d_out, int out_size, void* d_ws, size_t ws_size, hipStream_t stream) {
    static int grid = 0;
    if (grid == 0) {
        if (n_in != 33 || ws_size < WS_CTL + CTL_BYTES) { fprintf(stderr, "kernel_launch: n_in %d ws %zu (need %zu)\n", n_in, ws_size, (size_t)WS_END); grid = -1; return; }
        int dev = 0, cus = 0, per_cu = 0;
        hipGetDevice(&dev); hipDeviceGetAttribute(&cus, hipDeviceAttributeMultiprocessorCount, dev);
        if (hipFuncSetAttribute((const void*)mk_fwd, hipFuncAttributeMaxDynamicSharedMemorySize, LDS_BYTES) != hipSuccess) { fprintf(stderr, "hipFuncSetAttribute failed\n"); grid = -1; return; }
        hipOccupancyMaxActiveBlocksPerMultiprocessor(&per_cu, (const void*)mk_fwd, 512, LDS_BYTES);
        if (per_cu < 1) { fprintf(stderr, "occupancy query says %d\n", per_cu); per_cu = 1; }
        (void)hipGetLastError();
        grid = cus * 1;
    }
    if (grid < 0) return;
    (void)hipMemsetAsync((char*)d_ws + WS_CTL, 0, CTL_BYTES, stream);
    Params p{};
    for (int i = 0; i < 33; ++i) p.in[i] = (const float*)d_in[i];
    p.out = (float*)d_out; p.ws = (unsigned char*)d_ws;
#if MK_SINGLE
    p.ph_lo = 0; p.ph_hi = 2 * (NPH + (DUP_PHASE >= 0 ? 1 : 0) + NULLPH);
    void* args[] = {&p};
    hipError_t e = hipLaunchCooperativeKernel((const void*)mk_fwd, dim3(grid), dim3(512), args, LDS_BYTES, stream);
    if (e != hipSuccess) fprintf(stderr, "cooperative launch failed: %s (grid %d)\n", hipGetErrorString(e), grid);
#else
    for (int ph = 0; ph < 2 * NPH; ++ph) { p.ph_lo = ph; p.ph_hi = ph + 1; hipLaunchKernelGGL(mk_fwd, dim3(grid), dim3(512), LDS_BYTES, stream, p); }
#endif
}
```

```cpp
#include <hip/hip_runtime.h>
#include <hip/hip_cooperative_groups.h>
#include <cstdio>
#include <cstdint>
namespace cg = cooperative_groups;

#define LAS __attribute__((address_space(3)))
typedef unsigned short bf16_t;
typedef short bf16x8 __attribute__((ext_vector_type(8)));
typedef short bf16x4 __attribute__((ext_vector_type(4)));
typedef float f32x4 __attribute__((ext_vector_type(4)));
typedef float f32x2 __attribute__((ext_vector_type(2)));
typedef unsigned u32x4 __attribute__((ext_vector_type(4)));
typedef unsigned u32x2 __attribute__((ext_vector_type(2)));

constexpr int D_MODEL = 1024, NPROMPT_ROWS = 32768, MTOT = 34816;
constexpr int D_INNER = 2048, CONV_DIM = 3072, D_FF = 2816, D_FF2 = 5632;
constexpr float EPS = 1e-6f;
constexpr int NPH = 23;
constexpr size_t O_Y = 0, O_PSSM = 35651584, O_PSSMCONV = 39845888, O_PFFN = 39993344, O_PLAT = 40353792, O_PKPE = 48742400,
                 O_SSSM = 50839552, O_SSSMCONV = 59228160, O_SFFN = 59523072, O_SLAT = 60243968, O_SKPE = 60768256;
constexpr size_t WS_WIN = 0;
constexpr size_t WS_WOUT = WS_WIN + 5376ull * 1024 * 2;
constexpr size_t WS_WUP = WS_WOUT + 1024ull * 2048 * 2;
constexpr size_t WS_WDOWN = WS_WUP + 2ull * 5632 * 1024 * 2;
constexpr size_t WS_WKV = WS_WDOWN + 2ull * 1024 * 2816 * 2;
constexpr size_t WS_WDQ = WS_WKV + 512ull * 1024 * 2;
constexpr size_t WS_WUQ = WS_WDQ + 512ull * 1024 * 2;
constexpr size_t WS_WUK = WS_WUQ + 3072ull * 384 * 2;
constexpr size_t WS_WUV = WS_WUK + 4096ull * 128 * 2;
constexpr size_t WS_WO = WS_WUV + 2048ull * 640 * 2;
constexpr size_t WS_XN = WS_WO + 1024ull * 2048 * 2;
constexpr size_t WS_KC = WS_XN + 18432ull * 1024 * 2;
constexpr size_t WS_VT = WS_KC + 83968ull * 320 * 2;
constexpr size_t WS_BIG = WS_VT + 83968ull * 256 * 2;
constexpr size_t BIG_BYTES = 323223552ull;
constexpr size_t WS_END = WS_BIG + BIG_BYTES;
constexpr size_t MiB = 1u << 20;
constexpr size_t B_Z = 0, B_XBC = 75497472, B_DTP = 188743680, B_Y = 75497472;
constexpr size_t B_Y1A = 150994944;
constexpr size_t B_XST = 191102976, B_BC = 266600448, B_BT = 285474816, B_CC = 304349184;
constexpr size_t B_MIX0 = 0;
constexpr size_t B_U = 0, B_ACT = 207618048, B_F = 0;
constexpr size_t B_XNKV = 207618048, B_KVRAW = 100 * MiB, B_CQRAW = 144 * MiB;
constexpr size_t B_PART0 = 191102976, B_PART1 = 100 * MiB, B_PART2 = 200 * MiB;
constexpr size_t B_CQ = 0, B_QNOPE = 16 * MiB, B_QF = 100 * MiB, B_O2 = 16 * MiB, B_MIX1 = 100 * MiB;

constexpr int LDS_BYTES = 163840;
#ifndef PHASE_MASK
#define PHASE_MASK 0xFFFFFFFFu
#endif
#define PHM(x) (((PHASE_MASK) >> (x)) & 1u)

__device__ __forceinline__ unsigned f2bf(float f) { unsigned u = __builtin_bit_cast(unsigned, f); return (u + 0x7fffu + ((u >> 16) & 1u)) >> 16; }
__device__ __forceinline__ unsigned pk2(float lo, float hi) { unsigned r; asm("v_cvt_pk_bf16_f32 %0, %1, %2" : "=v"(r) : "v"(lo), "v"(hi)); return r; }
__device__ __forceinline__ float bf2f(unsigned h) { return __builtin_bit_cast(float, h << 16); }
__device__ __forceinline__ float bflo(unsigned w) { return __builtin_bit_cast(float, w << 16); }
__device__ __forceinline__ float bfhi(unsigned w) { return __builtin_bit_cast(float, w & 0xffff0000u); }
__device__ __forceinline__ float wave_sum(float v) {
#pragma unroll
    for (int o = 1; o < 64; o <<= 1) v += __shfl_xor(v, o);
    return v;
}
__device__ __forceinline__ float silu_f(float v) { return v * __builtin_amdgcn_rcpf(1.f + __expf(-v)); }
__device__ __forceinline__ float gelu_tanh_f(float v) { const float u = 0.7978845608f * (v + 0.044715f * v * v * v); return v * __builtin_amdgcn_rcpf(1.f + __expf(-2.f * u)); }
__device__ __forceinline__ float softplus_f(float x) { return fmaxf(x, 0.f) + log1pf(__expf(-fabsf(x))); }
__device__ __forceinline__ void sincos_rev(float ang, float& s, float& c) { float f = ang * 0.15915494309f; f = f - floorf(f); s = __builtin_amdgcn_sinf(f); c = __builtin_amdgcn_cosf(f); }
__device__ __forceinline__ void row_decode(int r, int& seq, int& t, int& T) {
    if (r < NPROMPT_ROWS) { seq = r >> 11; t = r & 2047; T = 2048; } else { const int q = r - NPROMPT_ROWS; seq = 16 + (q >> 6); t = q & 63; T = 64; }
}

namespace pg8 {
constexpr int BM = 256, BK = 64, HALF = 128, HTB = HALF * BK * 2, STAGE_BYTES = 8 * HTB, NXCD = 8, WGM = 8;
__host__ __device__ __forceinline__ int lds_byte(int r, int c) { const int st = (r >> 4) * 2 + (c >> 5), rr = r & 15, cc = c & 31, ob = rr * 64 + cc * 2; return st * 1024 + (ob ^ (((ob >> 9) & 1) << 5)); }
__host__ __device__ __forceinline__ void stage_rc(int b, int& R, int& C) { const int st = b / 1024, sb = b % 1024, swz = sb ^ (((sb >> 9) & 1) << 5); R = (st >> 1) * 16 + swz / 64; C = (st & 1) * 32 + (swz % 64) / 2; }
__host__ __device__ __forceinline__ int perm32(int rho) { const int n = rho >> 4, i = rho & 15; return 8 * (i >> 2) + 4 * n + (i & 3); }
struct Unit { int pm, pn; };
struct Gemm { const bf16_t* A; const bf16_t* Bt; int M, N, K, lda, ldb, a_pn_step, ncol, kpart; };
struct StaticOrder {
    int nM, nN, nwg, G, c;
    __device__ void init(int M, int N, int G_, int c_) { nM = M / BM; nN = N / BM; nwg = nM * nN; G = G_; c = c_; }
    __device__ bool next(int i, Unit& u) const {
        const long L = (long)i * G + c; if (L >= nwg) return false;
        int wgid = (int)L; { const int q = nwg / NXCD, r = nwg % NXCD, xcd = wgid % NXCD, off = wgid / NXCD; wgid = (xcd < r ? xcd * (q + 1) : r * (q + 1) + (xcd - r) * q) + off; }
        const int nig = WGM * nN, gid = wgid / nig, fm = gid * WGM, gsz = (nM - fm) < WGM ? (nM - fm) : WGM;
        u.pm = fm + ((wgid % nig) % gsz); u.pn = (wgid % nig) / gsz; return true;
    }
};
template <class Epi>
__device__ __forceinline__ void gemm_phase(LAS unsigned char* lds, const Gemm g, const StaticOrder& S, const Epi& E, const int tid) {
    const int wid = __builtin_amdgcn_readfirstlane(tid >> 6), lane = tid & 63, wr = wid >> 2, wc = wid & 3, fr = lane & 15, fq = lane >> 4;
    int K = g.K; asm volatile("" : "+s"(K)); K = __builtin_amdgcn_readfirstlane(K); const int nt = K / BK;
    unsigned voffA[2], voffB[2];
#pragma unroll
    for (int i = 0; i < 2; ++i) { int R, C; stage_rc(tid * 16 + i * 8192, R, C); const int Rb = Epi::PERM ? ((R & ~31) + perm32(R & 31)) : R;
        voffA[i] = (unsigned)(R * g.lda + C) * 2u; voffB[i] = (unsigned)(Rb * g.ldb + C) * 2u; }
    const size_t kstep = (size_t)(BK * 2);
    const size_t hstepA = (size_t)HALF * g.lda * 2, hstepB = (size_t)HALF * g.ldb * 2;
    const size_t tstepA = 2 * hstepA, tstepB = 2 * hstepB, pnstepA = (size_t)g.a_pn_step * 2;
    const unsigned ldsw = (unsigned)wid * 1024u;
    const int aoff = lds_byte(wr * 64 + fr, fq * 8), boff = lds_byte(wc * 32 + fr, fq * 8);
#define PG8_SA(b, h) (((b) * 2 + (h)) * HTB)
#define PG8_SB(b, h) ((4 + (b) * 2 + (h)) * HTB)
#define PG8_STAGE(bufoff, gbase, voff) do { _Pragma("unroll") for (int _i = 0; _i < 2; ++_i) \
        __builtin_amdgcn_global_load_lds((const unsigned*)((const char*)(gbase) + (voff)[_i]), (LAS unsigned*)(lds + (bufoff) + ldsw + _i * 8192), 16, 0, 0); } while (0)
#define PG8_LDA(dst, b, h) do { _Pragma("unroll") for (int m = 0; m < 4; ++m) _Pragma("unroll") for (int k = 0; k < 2; ++k) dst[m][k] = *(const LAS bf16x8*)(lds + PG8_SA(b, h) + aoff + m * 2048 + k * 1024); } while (0)
#define PG8_LDB(dst, b, h) do { _Pragma("unroll") for (int n = 0; n < 2; ++n) _Pragma("unroll") for (int k = 0; k < 2; ++k) dst[n][k] = *(const LAS bf16x8*)(lds + PG8_SB(b, h) + boff + n * 2048 + k * 1024); } while (0)
#define PG8_MMA(ai, bj, At, Bt) do { __builtin_amdgcn_s_setprio(1); _Pragma("unroll") for (int m = 0; m < 4; ++m) _Pragma("unroll") for (int n = 0; n < 2; ++n) _Pragma("unroll") for (int k = 0; k < 2; ++k) \
        acc[ai][bj][m][n] = __builtin_amdgcn_mfma_f32_16x16x32_bf16(Bt[n][k], At[m][k], acc[ai][bj][m][n], 0, 0, 0); __builtin_amdgcn_s_setprio(0); } while (0)
#define PG8_WAIT_V(n) asm volatile("s_waitcnt vmcnt(" #n ")" ::: "memory")
#define PG8_WAIT_L(n) asm volatile("s_waitcnt lgkmcnt(" #n ")" ::: "memory")
#define PG8_BAR __builtin_amdgcn_s_barrier()
#define PG8_SCHED __builtin_amdgcn_sched_barrier(0)
    Unit cur, nxt; int ui = 0;
    if (!S.next(0, cur)) return;
    f32x4 acc[2][2][4][2];
#pragma unroll
    for (int a = 0; a < 2; ++a)
#pragma unroll
        for (int b = 0; b < 2; ++b)
#pragma unroll
            for (int m = 0; m < 4; ++m)
#pragma unroll
                for (int n = 0; n < 2; ++n) acc[a][b][m][n] = (f32x4){0.f, 0.f, 0.f, 0.f};
    bf16x8 At[4][2], B0[2][2], B1[2][2];
#define PG8_OFFA(u) (g.ncol ? (size_t)(u).pm * tstepA + (size_t)((u).pn / g.ncol) * (size_t)g.kpart * 2 : (size_t)(u).pm * tstepA + (size_t)(u).pn * pnstepA)
#define PG8_OFFB(u) (g.ncol ? (size_t)((u).pn % g.ncol) * tstepB + (size_t)((u).pn / g.ncol) * (size_t)g.kpart * 2 : (size_t)(u).pn * tstepB)
    const char* cA = (const char*)g.A + PG8_OFFA(cur); const char* cB = (const char*)g.Bt + PG8_OFFB(cur);
    PG8_STAGE(PG8_SB(0, 0), cB, voffB); PG8_STAGE(PG8_SB(0, 1), cB + hstepB, voffB); PG8_STAGE(PG8_SA(0, 0), cA, voffA); PG8_STAGE(PG8_SA(0, 1), cA + hstepA, voffA);
    if (wr == 1) PG8_BAR;
    PG8_WAIT_V(2); PG8_BAR;
    PG8_STAGE(PG8_SB(1, 0), cB + kstep, voffB); PG8_STAGE(PG8_SA(1, 0), cA + kstep, voffA); PG8_STAGE(PG8_SB(1, 1), cB + hstepB + kstep, voffB);
    PG8_WAIT_V(6); PG8_BAR;
    for (;;) {
        const bool has_next = S.next(ui + 1, nxt);
        const char* nA = has_next ? (const char*)g.A + PG8_OFFA(nxt) : cA; const char* nB = has_next ? (const char*)g.Bt + PG8_OFFB(nxt) : cB;
        for (int t = 0; t < nt; t += 2) {
            const bool last = (t == nt - 2);
            const char* a1 = cA + (size_t)(t + 1) * kstep;
            const char* a2 = last ? nA : cA + (size_t)(t + 2) * kstep; const char* b2 = last ? nB : cB + (size_t)(t + 2) * kstep;
            const char* a3 = a2 + kstep; const char* b3 = b2 + kstep;
            PG8_LDB(B0, 0, 0); PG8_LDB(B1, 0, 1); PG8_SCHED; PG8_LDA(At, 0, 0); PG8_STAGE(PG8_SA(1, 1), a1 + hstepA, voffA);
            PG8_WAIT_V(8); PG8_WAIT_L(0); PG8_BAR; PG8_MMA(0, 0, At, B0); PG8_MMA(0, 1, At, B1); PG8_BAR; PG8_SCHED;
            PG8_LDA(At, 0, 1); PG8_STAGE(PG8_SB(0, 0), b2, voffB); PG8_STAGE(PG8_SB(0, 1), b2 + hstepB, voffB); PG8_STAGE(PG8_SA(0, 0), a2, voffA);
            PG8_WAIT_V(8); PG8_WAIT_L(0); PG8_BAR; PG8_MMA(1, 0, At, B0); PG8_MMA(1, 1, At, B1); PG8_BAR; PG8_SCHED;
            PG8_LDB(B0, 1, 0); PG8_LDB(B1, 1, 1); PG8_SCHED; PG8_LDA(At, 1, 0); PG8_STAGE(PG8_SA(0, 1), a2 + hstepA, voffA);
            PG8_WAIT_V(8); PG8_WAIT_L(0); PG8_BAR; PG8_MMA(0, 0, At, B0); PG8_MMA(0, 1, At, B1); PG8_BAR; PG8_SCHED;
            PG8_LDA(At, 1, 1); PG8_STAGE(PG8_SB(1, 0), b3, voffB); PG8_STAGE(PG8_SB(1, 1), b3 + hstepB, voffB); PG8_STAGE(PG8_SA(1, 0), a3, voffA);
            PG8_WAIT_V(8); PG8_WAIT_L(0); PG8_BAR; PG8_MMA(1, 0, At, B0); PG8_MMA(1, 1, At, B1); PG8_BAR; PG8_SCHED;
        }
        if (wr == 0) PG8_BAR;
        { int le; asm volatile("v_mbcnt_lo_u32_b32 %0, -1, 0\n\tv_mbcnt_hi_u32_b32 %0, -1, %0" : "=v"(le));
          E(acc, cur, wr, wc, le & 15, le >> 4); }
        if (!has_next) break;
#pragma unroll
        for (int a = 0; a < 2; ++a)
#pragma unroll
            for (int b = 0; b < 2; ++b)
#pragma unroll
                for (int m = 0; m < 4; ++m)
#pragma unroll
                    for (int n = 0; n < 2; ++n) acc[a][b][m][n] = (f32x4){0.f, 0.f, 0.f, 0.f};
        cur = nxt; cA = nA; cB = nB; ++ui;
        if (wr == 1) PG8_BAR;
    }
    PG8_WAIT_V(0);
    PG8_BAR;
#undef PG8_OFFA
#undef PG8_OFFB
#undef PG8_SA
#undef PG8_SB
#undef PG8_STAGE
#undef PG8_LDA
#undef PG8_LDB
#undef PG8_MMA
#undef PG8_WAIT_V
#undef PG8_WAIT_L
#undef PG8_BAR
#undef PG8_SCHED
}
}
using pg8::Unit;
typedef f32x4 Acc[2][2][4][2];

__device__ __forceinline__ u32x4 pack8(const f32x4 v0, const f32x4 v1) { u32x4 w; w.x = pk2(v0[0], v0[1]); w.y = pk2(v0[2], v0[3]); w.z = pk2(v1[0], v1[1]); w.w = pk2(v1[2], v1[3]); return w; }

struct EpiF32 { static constexpr bool PERM = false; float* O; int ldc;
    __device__ __forceinline__ void operator()(const Acc& acc, const Unit& u, int wr, int wc, int fr, int fq) const {
        const int row0 = u.pm * 256 + wr * 64 + fr, col0 = u.pn * 256 + wc * 32 + 4 * fq;
#pragma unroll
        for (int ai = 0; ai < 2; ++ai)
#pragma unroll
            for (int m = 0; m < 4; ++m) { float* rowp = O + (size_t)(row0 + ai * 128 + m * 16) * ldc + col0;
#pragma unroll
                for (int bj = 0; bj < 2; ++bj)
#pragma unroll
                    for (int n = 0; n < 2; ++n) *(f32x4*)(rowp + bj * 128 + n * 16) = acc[ai][bj][m][n]; }
    }
};
struct EpiF32Part { static constexpr bool PERM = false; float* O;
    __device__ __forceinline__ void operator()(const Acc& acc, const Unit& u, int wr, int wc, int fr, int fq) const {
        const int kp = u.pn >> 2, ct = u.pn & 3; const int row0 = u.pm * 256 + wr * 64 + fr, col0 = ct * 256 + wc * 32 + 4 * fq; float* base = O + (size_t)kp * 2048 * 1024;
#pragma unroll
        for (int ai = 0; ai < 2; ++ai)
#pragma unroll
            for (int m = 0; m < 4; ++m) { float* rowp = base + (size_t)(row0 + ai * 128 + m * 16) * 1024 + col0;
#pragma unroll
                for (int bj = 0; bj < 2; ++bj)
#pragma unroll
                    for (int n = 0; n < 2; ++n) *(f32x4*)(rowp + bj * 128 + n * 16) = acc[ai][bj][m][n]; }
    }
};
struct EpiBf16 { static constexpr bool PERM = true; bf16_t* O; int ldc; float* st_p; float* st_s; int m0;
    __device__ __forceinline__ void operator()(const Acc& acc, const Unit& u, int wr, int wc, int fr, int fq) const {
        const int row0 = u.pm * 256 + wr * 64 + fr, col0 = u.pn * 256 + wc * 32 + 8 * fq;
#pragma unroll
        for (int ai = 0; ai < 2; ++ai)
#pragma unroll
            for (int m = 0; m < 4; ++m) { const int lrow = row0 + ai * 128 + m * 16; bf16_t* rowp = O + (size_t)lrow * ldc + col0;
#pragma unroll
                for (int bj = 0; bj < 2; ++bj) *(u32x4*)(rowp + bj * 128) = pack8(acc[ai][bj][m][0], acc[ai][bj][m][1]);
                if (st_p) { int seq, t, T; row_decode(m0 + lrow, seq, t, T); const int idx = t - (T - 2);
                    if (idx >= 0) { float* o = (seq < 16 ? st_p + (size_t)(seq * 2 + idx) * D_FF2 : st_s + (size_t)((seq - 16) * 2 + idx) * D_FF2) + col0;
#pragma unroll
                        for (int bj = 0; bj < 2; ++bj) { *(f32x4*)(o + bj * 128) = acc[ai][bj][m][0]; *(f32x4*)(o + bj * 128 + 4) = acc[ai][bj][m][1]; } } }
            }
    }
};
struct EpiInProj { static constexpr bool PERM = true; bf16_t* Z; bf16_t* XBC; float* DTP; const float* dt_bias; float* out; int m0;
    __device__ __forceinline__ void operator()(const Acc& acc, const Unit& u, int wr, int wc, int fr, int fq) const {
        const int row0 = u.pm * 256 + wr * 64 + fr;
        if (u.pn < 20) {
            bf16_t* base; int ld, colt; const bool isx = u.pn >= 8;
            if (!isx) { base = Z; ld = 2048; colt = u.pn * 256; } else { base = XBC; ld = 3072; colt = (u.pn - 8) * 256; }
            const int col0 = colt + wc * 32 + 8 * fq;
#pragma unroll
            for (int ai = 0; ai < 2; ++ai)
#pragma unroll
                for (int m = 0; m < 4; ++m) { const int lrow = row0 + ai * 128 + m * 16; bf16_t* rowp = base + (size_t)lrow * ld + col0;
#pragma unroll
                    for (int bj = 0; bj < 2; ++bj) *(u32x4*)(rowp + bj * 128) = pack8(acc[ai][bj][m][0], acc[ai][bj][m][1]);
                    if (isx) { int seq, t, T; row_decode(m0 + lrow, seq, t, T); const int idx = t - (T - 3);
                        if (idx >= 0) { float* o = out + (seq < 16 ? O_PSSMCONV + (size_t)(seq * 3 + idx) * CONV_DIM : O_SSSMCONV + (size_t)((seq - 16) * 3 + idx) * CONV_DIM) + col0;
#pragma unroll
                            for (int bj = 0; bj < 2; ++bj) { *(f32x4*)(o + bj * 128) = acc[ai][bj][m][0]; *(f32x4*)(o + bj * 128 + 4) = acc[ai][bj][m][1]; } } }
                }
        } else if (wc == 0) {
#pragma unroll
            for (int ai = 0; ai < 2; ++ai)
#pragma unroll
                for (int m = 0; m < 4; ++m) { const int lrow = row0 + ai * 128 + m * 16;
#pragma unroll
                    for (int n = 0; n < 2; ++n) { const int h0 = 8 * fq + 4 * n; f32x4 v = acc[ai][0][m][n]; f32x4 o;
#pragma unroll
                        for (int j = 0; j < 4; ++j) o[j] = softplus_f(v[j] + dt_bias[h0 + j]);
                        *(f32x4*)(DTP + (size_t)lrow * 32 + h0) = o; } }
        }
    }
};
struct EpiUq { static constexpr bool PERM = true; bf16_t* QN; bf16_t* QF;
    __device__ __forceinline__ void operator()(const Acc& acc, const Unit& u, int wr, int wc, int fr, int fq) const {
        const int row0 = u.pm * 256 + wr * 64 + fr;
#pragma unroll
        for (int bj = 0; bj < 2; ++bj) { bf16_t* dst; size_t ld;
            if (u.pn < 8) { dst = QN + u.pn * 256 + bj * 128 + wc * 32 + 8 * fq; ld = 2048; }
            else { const int c = (u.pn - 8) * 256 + bj * 128 + wc * 32 + 8 * fq; dst = QF + (c >> 6) * 320 + 256 + (c & 63); ld = 5120; }
#pragma unroll
            for (int ai = 0; ai < 2; ++ai)
#pragma unroll
                for (int m = 0; m < 4; ++m) { const int lrow = row0 + ai * 128 + m * 16; *(u32x4*)(dst + (size_t)lrow * ld) = pack8(acc[ai][bj][m][0], acc[ai][bj][m][1]); } }
    }
};
struct EpiQlat { static constexpr bool PERM = true; bf16_t* QF; float scale;
    __device__ __forceinline__ void operator()(const Acc& acc, const Unit& u, int wr, int wc, int fr, int fq) const {
        const int row0 = u.pm * 256 + wr * 64 + fr, col0 = u.pn * 320 + wc * 32 + 8 * fq;
#pragma unroll
        for (int ai = 0; ai < 2; ++ai)
#pragma unroll
            for (int m = 0; m < 4; ++m) { bf16_t* rowp = QF + (size_t)(row0 + ai * 128 + m * 16) * 5120 + col0;
#pragma unroll
                for (int bj = 0; bj < 2; ++bj) *(u32x4*)(rowp + bj * 128) = pack8(acc[ai][bj][m][0] * scale, acc[ai][bj][m][1] * scale); }
    }
};

struct Params { const float* in[33]; float* out; unsigned char* ws; int ph_lo, ph_hi; };

__device__ __forceinline__ void transpose_item(const float* W, int N, bf16_t* WT, int ldo, int row_off, LAS float* scr, int item, int lane, const float* gk = nullptr) {
    const int nblk = N / 32, kb = item / nblk, nb = item % nblk, k0 = 64 * kb, n0 = 32 * nb;
#pragma unroll 8
    for (int i = 0; i < 32; ++i) { const int kk = 2 * i + (lane >> 5); float w = W[(size_t)(k0 + kk) * N + n0 + (lane & 31)]; if (gk) w *= gk[k0 + kk]; scr[kk * 33 + (lane & 31)] = w; }
    asm volatile("s_waitcnt lgkmcnt(0)" ::: "memory");
    const int c = lane & 7;
#pragma unroll
    for (int j = 0; j < 4; ++j) { const int n = (lane >> 3) + 8 * j; const LAS float* s = scr + (8 * c) * 33 + n;
        u32x4 o; o.x = pk2(s[0 * 33], s[1 * 33]); o.y = pk2(s[2 * 33], s[3 * 33]); o.z = pk2(s[4 * 33], s[5 * 33]); o.w = pk2(s[6 * 33], s[7 * 33]);
        *(u32x4*)(WT + (size_t)(row_off + n0 + n) * ldo + k0 + 8 * c) = o; }
    asm volatile("s_waitcnt lgkmcnt(0)" ::: "memory");
}


#define XB_TMO      128
#define XB_XCNT(j)  (256  + 64 * (j))
#define XB_XSUB(j)  (1280 + 64 * (j))
#define XB_XGEN(j)  (2304 + 64 * (j))
#define XB_TOP      3328
#define XB_TOPGEN   3392
#define XCD_BAR_WORDS 3456
#define XB_SPIN_CAP (1u << 18)
__device__ __forceinline__ unsigned xb_ld(unsigned* p)              { return __hip_atomic_load(p, __ATOMIC_RELAXED, __HIP_MEMORY_SCOPE_AGENT); }
__device__ __forceinline__ unsigned xb_add(unsigned* p, unsigned v) { return __hip_atomic_fetch_add(p, v, __ATOMIC_RELAXED, __HIP_MEMORY_SCOPE_AGENT); }
__device__ __forceinline__ unsigned xb_xcc_id() { return (unsigned)__builtin_amdgcn_s_getreg((3 << 11) | 20) & 0xFu; }
#define XB_SPIN(cond, bar) do { unsigned _sp = 0; while (cond) { __builtin_amdgcn_s_sleep(1); \
    if ((++_sp & 255u) == 0u) { if (xb_ld(&(bar)[XB_TMO])) break; if (_sp > XB_SPIN_CAP) { atomicAdd(&(bar)[XB_TMO], 1u); break; } } } } while (0)
struct XcdBarrier { unsigned* bar; unsigned x; volatile LAS unsigned* st; };
__device__ __forceinline__ void xcd_barrier_complete(unsigned* bar, unsigned x, unsigned& nloc, unsigned& nx) {
    const unsigned G = gridDim.x * gridDim.y * gridDim.z;
    unsigned sum, cnt, mine, sp = 0u;
    for (;;) {
        sum = 0u; cnt = 0u; mine = 0u;
#pragma unroll
        for (unsigned j = 0; j < 16; ++j) { const unsigned c = xb_ld(&bar[XB_XCNT(j)]); sum += c; cnt += (c > 0u) ? 1u : 0u; mine = (j == x) ? c : mine; }
        if (sum == G) break;
        __builtin_amdgcn_s_sleep(1);
        if ((++sp & 255u) == 0u) { if (xb_ld(&bar[XB_TMO])) break; if (sp > XB_SPIN_CAP) { atomicAdd(&bar[XB_TMO], 1u); break; } }
    }
    nloc = mine > 0u ? mine : 1u; nx = cnt > 0u ? cnt : 1u;
}
__device__ __forceinline__ void xcd_barrier(const XcdBarrier& b) {
    asm volatile("s_waitcnt vmcnt(0)" ::: "memory");
    __syncthreads();
    if (threadIdx.x == 0) {
        unsigned* bar = b.bar;
        __builtin_amdgcn_s_waitcnt(0);
        unsigned nloc = b.st[0], nx = b.st[1];
        if (nloc == 0u) { xcd_barrier_complete(bar, b.x, nloc, nx); b.st[0] = nloc; b.st[1] = nx; }
        const unsigned old = xb_add(&bar[XB_XSUB(b.x)], 1u);
        const unsigned gen = old / nloc;
        if (old + 1u == (gen + 1u) * nloc) {
            __builtin_amdgcn_fence(__ATOMIC_RELEASE, "agent");
            asm volatile("s_waitcnt vmcnt(0)" ::: "memory");
            const unsigned og = xb_add(&bar[XB_TOP], 1u);
            const unsigned tg = og / nx;
            if (og + 1u == (tg + 1u) * nx) xb_add(&bar[XB_TOPGEN], 1u);
            else XB_SPIN(xb_ld(&bar[XB_TOPGEN]) == tg, bar);
            __builtin_amdgcn_fence(__ATOMIC_ACQUIRE, "agent");
            xb_add(&bar[XB_XGEN(b.x)], 1u);
            asm volatile("s_waitcnt vmcnt(0)" ::: "memory");
        } else {
            XB_SPIN(xb_ld(&bar[XB_XGEN(b.x)]) == gen, bar);
            __builtin_amdgcn_fence(__ATOMIC_ACQUIRE, "agent");
            asm volatile("s_waitcnt vmcnt(0)" ::: "memory");
        }
    }
    __syncthreads();
}
constexpr size_t WS_CTL = WS_END;
constexpr size_t CTL_BYTES = 16384;
constexpr int LDS_MISC = 163840 - 64;

__global__ void __launch_bounds__(512, 2) mk_fwd(Params P) {
    extern __shared__ __attribute__((aligned(16))) unsigned char lds_raw[];
    LAS unsigned char* lds = (LAS unsigned char*)lds_raw;
    cg::grid_group grid = cg::this_grid();
    const int ph_lo = P.ph_lo, ph_hi = P.ph_hi;
    if (threadIdx.x < 2) ((volatile LAS unsigned*)(lds + LDS_MISC))[threadIdx.x] = 0u;
    __syncthreads();
    if (threadIdx.x == 0) (void)xb_add((unsigned*)(P.ws + WS_CTL) + XB_XCNT(xb_xcc_id()), 1u);
    if (ph_hi == -12345) grid.sync();
    const int wave_s = __builtin_amdgcn_readfirstlane(threadIdx.x >> 6);
    for (int ph = ph_lo; ph < ph_hi; ++ph) {
        const __attribute__((address_space(4))) Params* pp; { unsigned long long v = (unsigned long long)__builtin_amdgcn_kernarg_segment_ptr(); asm volatile("" : "+s"(v));
            const unsigned lo = __builtin_amdgcn_readfirstlane((unsigned)v), hi = __builtin_amdgcn_readfirstlane((unsigned)(v >> 32)); pp = (const __attribute__((address_space(4))) Params*)(((unsigned long long)hi << 32) | lo); }
        int lane_o; asm volatile("v_mbcnt_lo_u32_b32 %0, -1, 0\n\tv_mbcnt_hi_u32_b32 %0, -1, %0" : "=v"(lane_o));
        const int tid = wave_s * 64 + lane_o;
        int bx = blockIdx.x; asm volatile("" : "+s"(bx)); bx = __builtin_amdgcn_readfirstlane(bx);
        int G = gridDim.x; asm volatile("" : "+s"(G)); G = __builtin_amdgcn_readfirstlane(G);
        unsigned char* ws = pp->ws;
        float* out = pp->out;
        const int lane = lane_o & 63, wave = wave_s;
        const int gw = bx * 8 + wave, NGW = G * 8;
        const int fr = lane & 15, fq = lane >> 4;
        bf16_t* WT_in = (bf16_t*)(ws + WS_WIN); bf16_t* WT_out = (bf16_t*)(ws + WS_WOUT); bf16_t* WT_up = (bf16_t*)(ws + WS_WUP); bf16_t* WT_down = (bf16_t*)(ws + WS_WDOWN);
        bf16_t* WT_kv = (bf16_t*)(ws + WS_WKV); bf16_t* WT_dq = (bf16_t*)(ws + WS_WDQ); bf16_t* WT_uq = (bf16_t*)(ws + WS_WUQ); bf16_t* WUK = (bf16_t*)(ws + WS_WUK);
        bf16_t* WUV = (bf16_t*)(ws + WS_WUV); bf16_t* WT_o = (bf16_t*)(ws + WS_WO);
        bf16_t* XN = (bf16_t*)(ws + WS_XN); bf16_t* KC = (bf16_t*)(ws + WS_KC); bf16_t* VT = (bf16_t*)(ws + WS_VT);
        unsigned char* big = ws + WS_BIG;
        bf16_t* KCS = KC + 8ull * 2048 * 320; bf16_t* VTS = VT + 8ull * 256 * 2048;
#ifndef DUP_PHASE
#define DUP_PHASE -1
#endif
#ifndef NULLPH
#define NULLPH 0
#endif
        constexpr int NPHQ = NPH + (DUP_PHASE >= 0 ? 1 : 0) + NULLPH;
        const int pass = ph / NPHQ; int kq = ph - pass * NPHQ;
        if (DUP_PHASE >= 0 && kq > DUP_PHASE) kq -= 1;
        const int k = kq >= NPH ? 999 : (kq <= 2 ? kq : (kq == 3 ? 100 : kq - 1));
        const int m0 = pass ? 16384 : 0, Mh = pass ? 18432 : 16384;
        pg8::StaticOrder S;
        if (k == 0 && PHM(0)) { asm volatile("; ==PHASE 0");
            LAS float* scr = (LAS float*)(lds + wave * 16384);
            if (pass == 0) {
                constexpr int I_IN = 16 * 161, I_OUT = 32 * 32, I_UP = 16 * 176, I_DOWN = 44 * 32, I_DKV = 16 * 8, I_KR = 16 * 2, I_DQ = 16 * 12, I_UQ = 6 * 96, I_O = 32 * 32;
                constexpr int NIT = I_IN + I_OUT + 2 * I_UP + 2 * I_DOWN + I_DKV + I_KR + I_DQ + I_UQ + I_O;
                for (int it = gw; it < NIT; it += NGW) {
                    int r = it;
                    if (r < I_IN) { transpose_item(pp->in[11], 5152, WT_in, 1024, 0, scr, r, lane); continue; } r -= I_IN;
                    if (r < I_OUT) { transpose_item(pp->in[18], 1024, WT_out, 2048, 0, scr, r, lane); continue; } r -= I_OUT;
                    if (r < I_UP) { transpose_item(pp->in[29], 5632, WT_up, 1024, 0, scr, r, lane); continue; } r -= I_UP;
                    if (r < I_UP) { transpose_item(pp->in[29] + 1024ull * 5632, 5632, WT_up + 5632ull * 1024, 1024, 0, scr, r, lane); continue; } r -= I_UP;
                    if (r < I_DOWN) { transpose_item(pp->in[32], 1024, WT_down, 2816, 0, scr, r, lane); continue; } r -= I_DOWN;
                    if (r < I_DOWN) { transpose_item(pp->in[32] + 2816ull * 1024, 1024, WT_down + 1024ull * 2816, 2816, 0, scr, r, lane); continue; } r -= I_DOWN;
                    if (r < I_DKV) { transpose_item(pp->in[20], 256, WT_kv, 1024, 0, scr, r, lane, pp->in[19]); continue; } r -= I_DKV;
                    if (r < I_KR) { transpose_item(pp->in[22], 64, WT_kv, 1024, 256, scr, r, lane, pp->in[19]); continue; } r -= I_KR;
                    if (r < I_DQ) { transpose_item(pp->in[25], 384, WT_kv, 1024, 320, scr, r, lane, pp->in[7] + 1024); continue; } r -= I_DQ;
                    if (r < I_UQ) { const int n0 = (r % 96) * 32, hh = n0 / 192, ww = n0 - hh * 192; const int dest = ww < 128 ? hh * 128 + ww : 2048 + hh * 64 + (ww - 128);
                        transpose_item(pp->in[27], 3072, WT_uq, 384, dest - n0, scr, r, lane); continue; } r -= I_UQ;
                    transpose_item(pp->in[28], 1024, WT_o, 2048, 0, scr, r, lane);
                }
                const size_t gt = (size_t)bx * 512 + tid, NT = (size_t)G * 512;
                for (size_t i = gt; i < 4096ull * 128; i += NT) { const int d = i & 127, n = (int)(i >> 7), h = n >> 8, r = n & 255; WUK[i] = (bf16_t)f2bf(pp->in[23][((size_t)r * 16 + h) * 128 + d]); }
                for (size_t i = gt; i < 2048ull * 640; i += NT) { const int kk = (int)(i % 640), n = (int)(i / 640), hp = n >> 8, j = (n >> 7) & 1, v = n & 127; const int r = kk - j * 320;
                    WUV[i] = (r >= 0 && r < 256) ? (bf16_t)f2bf(pp->in[24][((size_t)r * 16 + 2 * hp + j) * 128 + v]) : (bf16_t)0; }
            } else {
                const size_t gt = (size_t)bx * 512 + tid, NT = (size_t)G * 512;
                for (size_t i = gt; i < 32ull * 2048 * 40; i += NT) { const int cv = (int)(i % 40); const size_t rk = i / 40; const int sb = (int)(rk >> 11), key = (int)(rk & 2047);
                    const float* src = cv < 32 ? pp->in[5] + rk * 256 + cv * 8 : pp->in[6] + rk * 64 + (cv - 32) * 8;
                    const f32x4 a = *(const f32x4*)src, b = *(const f32x4*)(src + 4);
                    *(u32x4*)(KCS + ((size_t)sb * 2112 + key) * 320 + cv * 8) = pack8(a, b); }
            }
            const float* g = pp->in[7];
            for (int lrb = gw; lrb < Mh; lrb += 4 * NGW) { f32x4 v[4][4];
#pragma unroll
                for (int q = 0; q < 4; ++q) { const int lr = min(lrb + q * NGW, Mh - 1), r = m0 + lr; const float* xi = r < NPROMPT_ROWS ? pp->in[0] + (size_t)r * 1024 : pp->in[1] + (size_t)(r - NPROMPT_ROWS) * 1024;
#pragma unroll
                    for (int j = 0; j < 4; ++j) v[q][j] = ((const f32x4*)xi)[lane + 64 * j]; }
#pragma unroll
                for (int q = 0; q < 4; ++q) { const int lr = lrb + q * NGW; if (lr < Mh) { float ss = 0.f;
#pragma unroll
                    for (int j = 0; j < 4; ++j) ss += v[q][j][0] * v[q][j][0] + v[q][j][1] * v[q][j][1] + v[q][j][2] * v[q][j][2] + v[q][j][3] * v[q][j][3];
                    const float rr = __builtin_amdgcn_rsqf(wave_sum(ss) * (1.f / 1024.f) + EPS);
#pragma unroll
                    for (int j = 0; j < 4; ++j) { const f32x4 gg = ((const f32x4*)g)[lane + 64 * j]; u32x2 o; o.x = pk2(v[q][j][0] * rr * gg[0], v[q][j][1] * rr * gg[1]); o.y = pk2(v[q][j][2] * rr * gg[2], v[q][j][3] * rr * gg[3]);
                        ((u32x2*)(XN + (size_t)lr * 1024))[lane + 64 * j] = o; } } } }
        } else if (k == 1 && PHM(1)) { asm volatile("; ==PHASE 1");
            pg8::Gemm g{XN, WT_in, Mh, 5376, 1024, 1024, 1024, 0, 0, 0}; S.init(Mh, 5376, G, bx);
            EpiInProj E{(bf16_t*)(big + B_Z), (bf16_t*)(big + B_XBC), (float*)(big + B_DTP), pp->in[14], out, m0};
            pg8::gemm_phase<EpiInProj>(lds, g, S, E, tid);
        } else if (k == 2 && PHM(2)) { asm volatile("; ==PHASE 2");
            const bf16_t* XBC = (const bf16_t*)(big + B_XBC);
            bf16_t* XST = (bf16_t*)(big + B_XST); bf16_t* BC = (bf16_t*)(big + B_BC); bf16_t* BTg = (bf16_t*)(big + B_BT); bf16_t* CC = (bf16_t*)(big + B_CC);
            const float* cwg = pp->in[12]; const float* cbg = pp->in[13]; const float* stc = pp->in[3];
            LAS bf16_t* Tt = (LAS bf16_t*)lds;
            const int nun = (Mh / 64) * 48;
            const int l = tid >> 3, oc = tid & 7;
            for (int un0 = bx; un0 < nun; un0 += 3 * G) {
                u32x4 ov[3]; int cls[3], jbs[3];
                float rw[3][4][8];
#pragma unroll
                for (int q = 0; q < 3; ++q) { const int un = min(un0 + q * G, nun - 1); const int cl = un / 48, jb = un - cl * 48; const int c0 = jb * 64 + oc * 8; cls[q] = cl; jbs[q] = jb;
                    int seq, t0, T; row_decode(m0 + cl * 64, seq, t0, T);
#pragma unroll
                    for (int i = 0; i < 4; ++i) { const int t = t0 + l - 3 + i;
                        if (t >= 0) { const u32x4 w = *(const u32x4*)(XBC + (size_t)(cl * 64 + l - 3 + i) * CONV_DIM + c0);
#pragma unroll
                            for (int e = 0; e < 4; ++e) { rw[q][i][2 * e] = bflo(w[e]); rw[q][i][2 * e + 1] = bfhi(w[e]); } }
                        else if (seq >= 16) { const float* sp = stc + ((size_t)(seq - 16) * 3 + (3 + t)) * CONV_DIM + c0; const f32x4 a = *(const f32x4*)sp, b = *(const f32x4*)(sp + 4);
#pragma unroll
                            for (int e = 0; e < 4; ++e) { rw[q][i][e] = a[e]; rw[q][i][4 + e] = b[e]; } }
                        else {
#pragma unroll
                            for (int e = 0; e < 8; ++e) rw[q][i][e] = 0.f; } } }
#pragma unroll
                for (int q = 0; q < 3; ++q) { const int c0 = jbs[q] * 64 + oc * 8; float o[8];
                    { const f32x4 b0 = *(const f32x4*)(cbg + c0), b1 = *(const f32x4*)(cbg + c0 + 4);
#pragma unroll
                      for (int e = 0; e < 4; ++e) { o[e] = b0[e]; o[4 + e] = b1[e]; } }
#pragma unroll
                    for (int i = 0; i < 4; ++i) { const f32x4 w0 = *(const f32x4*)(cwg + (size_t)i * CONV_DIM + c0), w1 = *(const f32x4*)(cwg + (size_t)i * CONV_DIM + c0 + 4);
#pragma unroll
                        for (int e = 0; e < 4; ++e) { o[e] += w0[e] * rw[q][i][e]; o[4 + e] += w1[e] * rw[q][i][4 + e]; } }
#pragma unroll
                    for (int e = 0; e < 8; ++e) o[e] = silu_f(o[e]);
                    ov[q].x = pk2(o[0], o[1]); ov[q].y = pk2(o[2], o[3]); ov[q].z = pk2(o[4], o[5]); ov[q].w = pk2(o[6], o[7]); }
                __syncthreads();
#pragma unroll
                for (int q = 0; q < 3; ++q) { const bool valid = un0 + q * G < nun; const int cl = cls[q], jb = jbs[q];
                    if (valid && jb >= 40) *(u32x4*)(CC + (size_t)(cl * 64 + l) * 512 + (jb - 40) * 64 + oc * 8) = ov[q];
                    if (valid && jb >= 32 && jb < 40) *(u32x4*)(BC + (size_t)(cl * 64 + l) * 512 + (jb - 32) * 64 + oc * 8) = ov[q];
#pragma unroll
                    for (int e = 0; e < 4; ++e) { Tt[q * 4480 + (oc * 8 + 2 * e) * 70 + l] = (bf16_t)(ov[q][e] & 0xffff); Tt[q * 4480 + (oc * 8 + 2 * e + 1) * 70 + l] = (bf16_t)(ov[q][e] >> 16); } }
                __syncthreads();
#pragma unroll
                for (int q = 0; q < 3; ++q) { const bool valid = un0 + q * G < nun; const int cl = cls[q], jb = jbs[q];
                    if (valid && jb < 40) { const int c = tid >> 3, lv = tid & 7; u32x4 tv;
#pragma unroll
                        for (int e = 0; e < 4; ++e) tv[e] = *(const LAS unsigned*)(Tt + q * 4480 + c * 70 + lv * 8 + 2 * e);
                        bf16_t* d = jb < 32 ? XST + (((size_t)cl * 32 + jb) * 64 + c) * 64 + lv * 8 : BTg + (((size_t)cl * 4 + ((jb - 32) >> 1)) * 128 + ((jb - 32) & 1) * 64 + c) * 64 + lv * 8;
                        *(u32x4*)d = tv; } }
            }
        } else if (k == 100 && PHM(2)) { asm volatile("; ==PHASE 100");
            const int Hh = G >> 1;
            if (bx >= Hh) {
            const bf16_t* XST = (const bf16_t*)(big + B_XST); const bf16_t* BC = (const bf16_t*)(big + B_BC); const bf16_t* CC = (const bf16_t*)(big + B_CC);
            const float* DTP = (const float*)(big + B_DTP); bf16_t* Y1a = (bf16_t*)(big + B_Y1A); bf16_t* Y1b = (bf16_t*)(ws + WS_VT); const int Mhh = Mh >> 1;
            LAS bf16_t* Bm = (LAS bf16_t*)(lds);
            LAS bf16_t* Cm = (LAS bf16_t*)(lds + 17408);
            LAS bf16_t* xsT = (LAS bf16_t*)(lds + 34816);
            LAS float* sdt = (LAS float*)(lds + 108544);
            LAS float* sacs = sdt + 512;
            const int nun = (Mh / 64) * 4;
            for (int un = bx - Hh; un < nun; un += G - Hh) { const int cl = un >> 2, grp = un & 3; const int h = grp * 8 + wave;
                const float Ah = -__expf(pp->in[15][h]), Dh = pp->in[16][h];
                __syncthreads();
#pragma unroll
                for (int i = 0; i < 2; ++i) { const int v = tid + 512 * i, r = v >> 4, cv = v & 15; *(LAS u32x4*)(Bm + r * 136 + cv * 8) = *(const u32x4*)(BC + (size_t)(cl * 64 + r) * 512 + grp * 128 + cv * 8);
                    *(LAS u32x4*)(Cm + r * 136 + cv * 8) = *(const u32x4*)(CC + (size_t)(cl * 64 + r) * 512 + grp * 128 + cv * 8); }
#pragma unroll
                for (int i = 0; i < 8; ++i) { const int p = tid >> 3, lv = tid & 7; *(LAS u32x4*)(xsT + (i * 64 + p) * 72 + lv * 8) = *(const u32x4*)(XST + ((size_t)cl * 32 + grp * 8 + i) * 4096 + (size_t)tid * 8); }
                { const float dt = DTP[(size_t)(cl * 64 + lane) * 32 + h]; float a = dt * Ah;
#pragma unroll
                  for (int o = 1; o < 64; o <<= 1) { const float tv = __shfl_up(a, o); if (lane >= o) a += tv; }
                  sdt[wave * 64 + lane] = dt; sacs[wave * 64 + lane] = a; }
                __syncthreads();
                LAS const float* acs = sacs + wave * 64; LAS const float* dts = sdt + wave * 64; LAS const bf16_t* xh = xsT + wave * 64 * 72;
#pragma unroll
                for (int lb = 0; lb < 4; ++lb) { const int l_idx = lb * 16 + fr; const float acs_l = acs[l_idx];
                    f32x4 cb[4];
#pragma unroll
                    for (int sb = 0; sb < 4; ++sb) cb[sb] = (f32x4){0.f, 0.f, 0.f, 0.f};
#pragma unroll
                    for (int ks = 0; ks < 4; ++ks) { const bf16x8 bfr = *(const LAS bf16x8*)(Cm + l_idx * 136 + ks * 32 + fq * 8);
#pragma unroll
                        for (int sb = 0; sb < 4; ++sb) if (sb <= lb) { const bf16x8 afr = *(const LAS bf16x8*)(Bm + (sb * 16 + fr) * 136 + ks * 32 + fq * 8); cb[sb] = __builtin_amdgcn_mfma_f32_16x16x32_bf16(afr, bfr, cb[sb], 0, 0, 0); } }
                    bf16x8 wl[2];
#pragma unroll
                    for (int sb = 0; sb < 4; ++sb) { float wv[4];
#pragma unroll
                        for (int i = 0; i < 4; ++i) { const int sidx = sb * 16 + fq * 4 + i; wv[i] = (sb <= lb && sidx <= l_idx) ? cb[sb][i] * __expf(acs_l - acs[sidx]) * dts[sidx] : 0.f; }
                        const unsigned u0 = pk2(wv[0], wv[1]), u1 = pk2(wv[2], wv[3]); const int tt = sb >> 1, hf = sb & 1;
                        wl[tt][hf * 4 + 0] = (short)(u0 & 0xffff); wl[tt][hf * 4 + 1] = (short)(u0 >> 16); wl[tt][hf * 4 + 2] = (short)(u1 & 0xffff); wl[tt][hf * 4 + 3] = (short)(u1 >> 16); }
#pragma unroll
                    for (int pb = 0; pb < 4; ++pb) { f32x4 y = (f32x4){0.f, 0.f, 0.f, 0.f};
#pragma unroll
                        for (int tt = 0; tt < 2; ++tt) if (2 * tt <= lb) { const bf16x4 a0 = *(const LAS bf16x4*)(xh + (pb * 16 + fr) * 72 + 32 * tt + fq * 4), a1 = *(const LAS bf16x4*)(xh + (pb * 16 + fr) * 72 + 32 * tt + 16 + fq * 4);
                            const bf16x8 afr = (bf16x8){a0[0], a0[1], a0[2], a0[3], a1[0], a1[1], a1[2], a1[3]};
                            y = __builtin_amdgcn_mfma_f32_16x16x32_bf16(afr, wl[tt], y, 0, 0, 0); }
#pragma unroll
                        for (int i = 0; i < 4; ++i) y[i] += bf2f(xh[(pb * 16 + fq * 4 + i) * 72 + l_idx]) * Dh;
                        u32x2 o; o.x = pk2(y[0], y[1]); o.y = pk2(y[2], y[3]);
                        const int lr1 = cl * 64 + l_idx; bf16_t* y1 = lr1 < Mhh ? Y1a + (size_t)lr1 * D_INNER : Y1b + (size_t)(lr1 - Mhh) * D_INNER;
                        *(u32x2*)(y1 + h * 64 + pb * 16 + fq * 4) = o; } }
            }
            }
            {
            const bf16_t* XST = (const bf16_t*)(big + B_XST); const bf16_t* BTg = (const bf16_t*)(big + B_BT); const bf16_t* CC = (const bf16_t*)(big + B_CC);
            const float* DTP = (const float*)(big + B_DTP); bf16_t* Y = (bf16_t*)(big + B_Y);
            const int hl = wave >> 2, pq = wave & 3;
            const int nunits = pass ? 128 + 512 : 128;
            const int npr = bx < Hh ? (128 - bx + Hh - 1) / Hh : 0;
            for (int it = 0; ; ++it) { const int un = it < npr ? bx + it * Hh : 128 + bx + (it - npr) * G; if (un >= nunits) break;
                int seq, grp, hp;
                if (un < 128) { seq = (pass ? 8 : 0) + (un >> 4); grp = (un >> 2) & 3; hp = un & 3; } else { const int q = un - 128; seq = 16 + (q >> 4); grp = (q >> 2) & 3; hp = q & 3; }
                const bool smp = seq >= 16; const int nch = smp ? 1 : 32;
                const int lrow_base = (smp ? NPROMPT_ROWS + (seq - 16) * 64 : seq * 2048) - m0; const int cl_base = lrow_base >> 6;
                const int h = grp * 8 + hp * 2 + hl;
                const float Aw = -__expf(pp->in[15][grp * 8 + hp * 2 + (wave & 1)]);
                f32x4 st[8];
                { const float* sp = pp->in[2] + (((size_t)(smp ? seq - 16 : 0) * 32 + h) * 64 + pq * 16 + fr) * 128 + fq * 4;
#pragma unroll
                  for (int nb = 0; nb < 8; ++nb) { const f32x4 v = *(const f32x4*)(sp + nb * 16); st[nb] = smp ? v : (f32x4){0.f, 0.f, 0.f, 0.f}; } }
                u32x4 pf[6]; float pdt = 0.f; u32x2 yres[4];
#pragma unroll
                for (int lb = 0; lb < 4; ++lb) yres[lb] = (u32x2){0u, 0u};
#define SSD_PREFETCH(c_) do { const int c__ = (c_); const size_t rb_ = (size_t)(lrow_base + c__ * 64); \
                    _Pragma("unroll") for (int i = 0; i < 2; ++i) { const int v = tid + 512 * i, r = v >> 4, cv = v & 15; pf[i] = *(const u32x4*)(CC + (rb_ + r) * 512 + grp * 128 + cv * 8); \
                        pf[2 + i] = *(const u32x4*)(BTg + ((size_t)(cl_base + c__) * 4 + grp) * 8192 + (size_t)v * 8); \
                        pf[4 + i] = *(const u32x4*)(XST + ((size_t)(cl_base + c__) * 32 + grp * 8 + hp * 2 + i) * 4096 + (size_t)tid * 8); } \
                    if (wave < 2) pdt = DTP[(rb_ + lane) * 32 + grp * 8 + hp * 2 + wave]; } while (0)
#define SSD_WRITE(sg_) do { LAS unsigned char* sb_ = lds + (sg_) * 55296; LAS bf16_t* Cm_ = (LAS bf16_t*)sb_; LAS bf16_t* BT_ = (LAS bf16_t*)(sb_ + 17408); LAS bf16_t* xs_ = (LAS bf16_t*)(sb_ + 35840); LAS float* sa_ = (LAS float*)(sb_ + 54272); \
                    _Pragma("unroll") for (int i = 0; i < 2; ++i) { const int v = tid + 512 * i, r = v >> 4, cv = v & 15; *(LAS u32x4*)(Cm_ + r * 136 + cv * 8) = pf[i]; \
                        const int n = v >> 3, lv = v & 7; *(LAS u32x4*)(BT_ + n * 72 + lv * 8) = pf[2 + i]; \
                        const int p = tid >> 3, l8 = tid & 7; *(LAS u32x4*)(xs_ + (i * 64 + p) * 72 + l8 * 8) = pf[4 + i]; } \
                    if (wave < 2) { float a = pdt * Aw; \
                        _Pragma("unroll") for (int o = 1; o < 64; o <<= 1) { const float tv = __shfl_up(a, o); if (lane >= o) a += tv; } \
                        const float tot = __shfl(a, 63); \
                        sa_[wave * 64 + lane] = a; sa_[128 + wave * 64 + lane] = __expf(tot - a) * pdt; } } while (0)
                __syncthreads();
                SSD_PREFETCH(0);
                SSD_WRITE(0);
                SSD_PREFETCH((nch > 1 ? 1 : 0));
                __syncthreads();
                for (int c = 0; c < nch; ++c) {
                    if (c + 1 < nch) SSD_WRITE((c + 1) & 1);
                    if (c + 2 < nch) SSD_PREFETCH(c + 2);
                    if (c > 0) {
#pragma unroll
                        for (int lb = 0; lb < 4; ++lb) *(u32x2*)(Y + (size_t)(lrow_base + (c - 1) * 64 + lb * 16 + fr) * D_INNER + h * 64 + pq * 16 + fq * 4) = yres[lb]; }
                    LAS unsigned char* sbase = lds + (c & 1) * 55296;
                    LAS const bf16_t* Cm = (LAS const bf16_t*)sbase; LAS const bf16_t* BTl = (LAS const bf16_t*)(sbase + 17408); LAS const bf16_t* xsT = (LAS const bf16_t*)(sbase + 35840);
                    LAS const float* sacs = (LAS const float*)(sbase + 54272); LAS const float* sw = sacs + 128;
                    LAS const float* acs = sacs + hl * 64; LAS const float* sws = sw + hl * 64;
                    LAS const bf16_t* xh = xsT + hl * 64 * 72;
                    f32x4 ya[4];
#pragma unroll
                    for (int lb = 0; lb < 4; ++lb) ya[lb] = (f32x4){0.f, 0.f, 0.f, 0.f};
#pragma unroll
                    for (int tt = 0; tt < 4; ++tt) { const unsigned u0 = pk2(st[2 * tt][0], st[2 * tt][1]), u1 = pk2(st[2 * tt][2], st[2 * tt][3]), u2 = pk2(st[2 * tt + 1][0], st[2 * tt + 1][1]), u3 = pk2(st[2 * tt + 1][2], st[2 * tt + 1][3]);
                        const bf16x8 af = (bf16x8){(short)(u0 & 0xffff), (short)(u0 >> 16), (short)(u1 & 0xffff), (short)(u1 >> 16), (short)(u2 & 0xffff), (short)(u2 >> 16), (short)(u3 & 0xffff), (short)(u3 >> 16)};
#pragma unroll
                        for (int lb = 0; lb < 4; ++lb) { const bf16x4 b0 = *(const LAS bf16x4*)(Cm + (lb * 16 + fr) * 136 + 32 * tt + fq * 4), b1 = *(const LAS bf16x4*)(Cm + (lb * 16 + fr) * 136 + 32 * tt + 16 + fq * 4);
                            const bf16x8 bfr = (bf16x8){b0[0], b0[1], b0[2], b0[3], b1[0], b1[1], b1[2], b1[3]};
                            ya[lb] = __builtin_amdgcn_mfma_f32_16x16x32_bf16(af, bfr, ya[lb], 0, 0, 0); } }
#pragma unroll
                    for (int lb = 0; lb < 4; ++lb) { const float eal = __expf(acs[lb * 16 + fr]); const f32x4 y = ya[lb] * eal; u32x2 o;
                        o.x = pk2(y[0], y[1]); o.y = pk2(y[2], y[3]); yres[lb] = o; }
                    { const float dec = __expf(acs[63]);
#pragma unroll
                      for (int nb = 0; nb < 8; ++nb) st[nb] = st[nb] * dec;
#pragma unroll
                      for (int tt = 0; tt < 2; ++tt) { const f32x4 s0 = *(const LAS f32x4*)(sws + tt * 32 + fq * 8), s1 = *(const LAS f32x4*)(sws + tt * 32 + fq * 8 + 4);
                          const u32x4 xv = *(const LAS u32x4*)(xh + (pq * 16 + fr) * 72 + tt * 32 + fq * 8);
                          const unsigned u0 = pk2(bflo(xv[0]) * s0[0], bfhi(xv[0]) * s0[1]), u1 = pk2(bflo(xv[1]) * s0[2], bfhi(xv[1]) * s0[3]), u2 = pk2(bflo(xv[2]) * s1[0], bfhi(xv[2]) * s1[1]), u3 = pk2(bflo(xv[3]) * s1[2], bfhi(xv[3]) * s1[3]);
                          const bf16x8 xb = (bf16x8){(short)(u0 & 0xffff), (short)(u0 >> 16), (short)(u1 & 0xffff), (short)(u1 >> 16), (short)(u2 & 0xffff), (short)(u2 >> 16), (short)(u3 & 0xffff), (short)(u3 >> 16)};
#pragma unroll
                          for (int nb = 0; nb < 8; ++nb) { const bf16x8 afr = *(const LAS bf16x8*)(BTl + (nb * 16 + fr) * 72 + tt * 32 + fq * 8); st[nb] = __builtin_amdgcn_mfma_f32_16x16x32_bf16(afr, xb, st[nb], 0, 0, 0); } } }
                    __syncthreads();
                }
#undef SSD_WRITE
#undef SSD_PREFETCH
#pragma unroll
                for (int lb = 0; lb < 4; ++lb) *(u32x2*)(Y + (size_t)(lrow_base + (nch - 1) * 64 + lb * 16 + fr) * D_INNER + h * 64 + pq * 16 + fq * 4) = yres[lb];
                float* so = out + (smp ? O_SSSM + ((size_t)(seq - 16) * 32 + h) * 8192 : O_PSSM + ((size_t)seq * 32 + h) * 8192);
#pragma unroll
                for (int nb = 0; nb < 8; ++nb) *(f32x4*)(so + (pq * 16 + fr) * 128 + nb * 16 + fq * 4) = st[nb];
            }
            }
        } else if (k == 3 && PHM(3)) { asm volatile("; ==PHASE 3");
            const bf16_t* Z = (const bf16_t*)(big + B_Z); bf16_t* Y = (bf16_t*)(big + B_Y); const float* gn = pp->in[17];
            const bf16_t* Y1a = (const bf16_t*)(big + B_Y1A); const bf16_t* Y1b = (const bf16_t*)(ws + WS_VT); const int Mhh = Mh >> 1;
            for (int lrb = gw; lrb < Mh; lrb += 2 * NGW) { u32x4 yv[2][4], zv[2][4], y1v[2][4];
#pragma unroll
                for (int q = 0; q < 2; ++q) { const int lr = min(lrb + q * NGW, Mh - 1);
#pragma unroll
                    for (int gI = 0; gI < 4; ++gI) { const int col = gI * 512 + lane * 8; yv[q][gI] = *(const u32x4*)(Y + (size_t)lr * 2048 + col); zv[q][gI] = *(const u32x4*)(Z + (size_t)lr * 2048 + col);
                        y1v[q][gI] = *(const u32x4*)((lr < Mhh ? Y1a + (size_t)lr * 2048 : Y1b + (size_t)(lr - Mhh) * 2048) + col); } }
#pragma unroll
                for (int q = 0; q < 2; ++q) { const int lr = lrb + q * NGW; if (lr < Mh) {
#pragma unroll
                    for (int gI = 0; gI < 4; ++gI) { const int col = gI * 512 + lane * 8;
                        float v[8]; float ss = 0.f;
#pragma unroll
                        for (int e = 0; e < 4; ++e) { v[2 * e] = (bflo(yv[q][gI][e]) + bflo(y1v[q][gI][e])) * silu_f(bflo(zv[q][gI][e])); v[2 * e + 1] = (bfhi(yv[q][gI][e]) + bfhi(y1v[q][gI][e])) * silu_f(bfhi(zv[q][gI][e])); ss += v[2 * e] * v[2 * e] + v[2 * e + 1] * v[2 * e + 1]; }
                        const float rr = __builtin_amdgcn_rsqf(wave_sum(ss) * (1.f / 512.f) + EPS);
                        const f32x4 g0 = *(const f32x4*)(gn + col), g1 = *(const f32x4*)(gn + col + 4);
                        u32x4 o; o.x = pk2(v[0] * rr * g0[0], v[1] * rr * g0[1]); o.y = pk2(v[2] * rr * g0[2], v[3] * rr * g0[3]); o.z = pk2(v[4] * rr * g1[0], v[5] * rr * g1[1]); o.w = pk2(v[6] * rr * g1[2], v[7] * rr * g1[3]);
                        *(u32x4*)(Y + (size_t)lr * 2048 + col) = o; } } } }
        } else if (k == 4 && PHM(4)) { asm volatile("; ==PHASE 4");
            pg8::Gemm g{(const bf16_t*)(big + B_Y), WT_out, 16384, 1024, 2048, 2048, 2048, 0, 0, 0}; S.init(16384, 1024, G, bx);
            EpiBf16 E{(bf16_t*)(big + B_MIX0), 1024, nullptr, nullptr, m0}; pg8::gemm_phase<EpiBf16>(lds, g, S, E, tid);
        } else if ((k == 5 || k == 9 || k == 17 || k == 21) && PHM(5)) { asm volatile("; ==PHASE 5");
            const bf16_t* mix = (const bf16_t*)(big + (k == 5 ? B_MIX0 : (k == 17 ? B_MIX1 : B_F)));
            const float* part = (const float*)(big + (k == 5 ? B_PART0 : (k == 17 ? B_PART2 : B_PART1)));
            const float* gpost = k == 5 ? pp->in[8] : (k == 9 ? pp->in[10] : (k == 17 ? pp->in[8] + 1024 : pp->in[10] + 1024));
            const float* g1 = k == 5 ? pp->in[9] : (k == 9 ? pp->in[7] + 1024 : (k == 17 ? pp->in[9] + 1024 : nullptr));
            const float* g2 = nullptr; const bool plain = k == 9;
            bf16_t* XNKV = (bf16_t*)(big + B_XNKV);
            for (int lrb = gw; lrb < Mh; lrb += 4 * NGW) {
                f32x4 mv[4][4], xv[4][4];
#pragma unroll
                for (int q = 0; q < 4; ++q) { const int lr = min(lrb + q * NGW, Mh - 1), r = m0 + lr;
                    const float* xi = k == 5 ? (r < NPROMPT_ROWS ? pp->in[0] + (size_t)r * 1024 : pp->in[1] + (size_t)(r - NPROMPT_ROWS) * 1024) : out + O_Y + (size_t)r * 1024;
#pragma unroll
                    for (int j = 0; j < 4; ++j) xv[q][j] = ((const f32x4*)xi)[lane + 64 * j];
                    if (pass && lr >= 16384) { const float* pr = part + (size_t)(lr - 16384) * 1024;
#pragma unroll
                        for (int j = 0; j < 4; ++j) mv[q][j] = ((const f32x4*)pr)[lane + 64 * j] + ((const f32x4*)(pr + (size_t)2048 * 1024))[lane + 64 * j];
                        if (k == 5 || k == 17) {
#pragma unroll
                            for (int j = 0; j < 4; ++j) mv[q][j] = mv[q][j] + (((const f32x4*)(pr + (size_t)2 * 2048 * 1024))[lane + 64 * j] + ((const f32x4*)(pr + (size_t)3 * 2048 * 1024))[lane + 64 * j]); } }
                    else {
#pragma unroll
                        for (int j = 0; j < 4; ++j) { const u32x2 mw = ((const u32x2*)(mix + (size_t)lr * 1024))[lane + 64 * j]; mv[q][j] = (f32x4){bflo(mw.x), bfhi(mw.x), bflo(mw.y), bfhi(mw.y)}; } } }
#pragma unroll
                for (int q = 0; q < 4; ++q) { const int lr = lrb + q * NGW; if (lr < Mh) { const int r = m0 + lr; float ss = 0.f;
#pragma unroll
                    for (int j = 0; j < 4; ++j) ss += mv[q][j][0] * mv[q][j][0] + mv[q][j][1] * mv[q][j][1] + mv[q][j][2] * mv[q][j][2] + mv[q][j][3] * mv[q][j][3];
                    const float rr = __builtin_amdgcn_rsqf(wave_sum(ss) * (1.f / 1024.f) + EPS); float s2 = 0.f;
#pragma unroll
                    for (int j = 0; j < 4; ++j) { const f32x4 gg = ((const f32x4*)gpost)[lane + 64 * j]; xv[q][j] = xv[q][j] + mv[q][j] * rr * gg; ((f32x4*)(out + O_Y + (size_t)r * 1024))[lane + 64 * j] = xv[q][j];
                        s2 += xv[q][j][0] * xv[q][j][0] + xv[q][j][1] * xv[q][j][1] + xv[q][j][2] * xv[q][j][2] + xv[q][j][3] * xv[q][j][3]; }
                    if (g1) { const float r2 = __builtin_amdgcn_rsqf(wave_sum(s2) * (1.f / 1024.f) + EPS);
#pragma unroll
                        for (int j = 0; j < 4; ++j) { const f32x4 gg = plain ? (f32x4){1.f, 1.f, 1.f, 1.f} : ((const f32x4*)g1)[lane + 64 * j]; u32x2 o; o.x = pk2(xv[q][j][0] * r2 * gg[0], xv[q][j][1] * r2 * gg[1]); o.y = pk2(xv[q][j][2] * r2 * gg[2], xv[q][j][3] * r2 * gg[3]);
                            ((u32x2*)(XN + (size_t)lr * 1024))[lane + 64 * j] = o;
                            if (g2) { const f32x4 g3 = ((const f32x4*)g2)[lane + 64 * j]; u32x2 o2; o2.x = pk2(xv[q][j][0] * r2 * g3[0], xv[q][j][1] * r2 * g3[1]); o2.y = pk2(xv[q][j][2] * r2 * g3[2], xv[q][j][3] * r2 * g3[3]);
                                ((u32x2*)(XNKV + (size_t)lr * 1024))[lane + 64 * j] = o2; } } } } }
            }
        } else if ((k == 6 || k == 18) && PHM(6)) { asm volatile("; ==PHASE 6");
            const int layer = k == 6 ? 0 : 1;
            pg8::Gemm g{XN, WT_up + (size_t)layer * 5632 * 1024, Mh, 5632, 1024, 1024, 1024, 0, 0, 0}; S.init(Mh, 5632, G, bx);
            EpiBf16 E{(bf16_t*)(big + B_U), 5632, out + O_PFFN + (size_t)layer * 16 * 2 * D_FF2, out + O_SFFN + (size_t)layer * 32 * 2 * D_FF2, m0};
            pg8::gemm_phase<EpiBf16>(lds, g, S, E, tid);
        } else if ((k == 7 || k == 19) && PHM(7)) { asm volatile("; ==PHASE 7");
            const int layer = k == 7 ? 0 : 1;
            const bf16_t* U = (const bf16_t*)(big + B_U); bf16_t* ACT = (bf16_t*)(big + B_ACT);
            const float* cwt = pp->in[30] + (size_t)layer * 3 * D_FF2; const float* cbs = pp->in[31] + (size_t)layer * D_FF2; const float* stf = pp->in[4] + (size_t)layer * 32 * 2 * D_FF2;
            const int nstrip = pass ? 256 + 256 : Mh / 64;
            for (int sp = bx; sp < nstrip; sp += G) { const int lr0 = sp < 256 ? sp * 64 : 16384 + (sp - 256) * 8; const int nr = sp < 256 ? 64 : 8; int seq, t0, T; row_decode(m0 + lr0, seq, t0, T);
                if (tid < 352) { const int j0 = tid * 8;
                    float wv[3][8], wg[3][8], bv[8], bg[8], p1v[8], p2v[8], p1g[8], p2g[8];
#pragma unroll
                    for (int i = 0; i < 3; ++i) { const f32x4 a0 = *(const f32x4*)(cwt + (size_t)i * D_FF2 + j0), a1 = *(const f32x4*)(cwt + (size_t)i * D_FF2 + j0 + 4), g0 = *(const f32x4*)(cwt + (size_t)i * D_FF2 + D_FF + j0), g1 = *(const f32x4*)(cwt + (size_t)i * D_FF2 + D_FF + j0 + 4);
#pragma unroll
                        for (int e = 0; e < 4; ++e) { wv[i][e] = a0[e]; wv[i][4 + e] = a1[e]; wg[i][e] = g0[e]; wg[i][4 + e] = g1[e]; } }
                    { const f32x4 b0 = *(const f32x4*)(cbs + j0), b1 = *(const f32x4*)(cbs + j0 + 4), b2 = *(const f32x4*)(cbs + D_FF + j0), b3 = *(const f32x4*)(cbs + D_FF + j0 + 4);
#pragma unroll
                      for (int e = 0; e < 4; ++e) { bv[e] = b0[e]; bv[4 + e] = b1[e]; bg[e] = b2[e]; bg[4 + e] = b3[e]; } }
                    if (t0 > 0) { const u32x4 a = *(const u32x4*)(U + (size_t)(lr0 - 2) * D_FF2 + j0), b = *(const u32x4*)(U + (size_t)(lr0 - 2) * D_FF2 + D_FF + j0), c = *(const u32x4*)(U + (size_t)(lr0 - 1) * D_FF2 + j0), d = *(const u32x4*)(U + (size_t)(lr0 - 1) * D_FF2 + D_FF + j0);
#pragma unroll
                        for (int e = 0; e < 4; ++e) { p2v[2 * e] = bflo(a[e]); p2v[2 * e + 1] = bfhi(a[e]); p2g[2 * e] = bflo(b[e]); p2g[2 * e + 1] = bfhi(b[e]); p1v[2 * e] = bflo(c[e]); p1v[2 * e + 1] = bfhi(c[e]); p1g[2 * e] = bflo(d[e]); p1g[2 * e + 1] = bfhi(d[e]); } }
                    else if (seq >= 16) { const float* s2 = stf + ((size_t)(seq - 16) * 2 + 0) * D_FF2 + j0; const float* s1 = s2 + D_FF2;
#pragma unroll
                        for (int e = 0; e < 8; ++e) { p2v[e] = s2[e]; p2g[e] = s2[D_FF + e]; p1v[e] = s1[e]; p1g[e] = s1[D_FF + e]; } }
                    else {
#pragma unroll
                        for (int e = 0; e < 8; ++e) { p2v[e] = 0.f; p2g[e] = 0.f; p1v[e] = 0.f; p1g[e] = 0.f; } }
#pragma unroll 8
                    for (int r = 0; r < nr; ++r) { const u32x4 a = *(const u32x4*)(U + (size_t)(lr0 + r) * D_FF2 + j0), b = *(const u32x4*)(U + (size_t)(lr0 + r) * D_FF2 + D_FF + j0);
                        float cv[8], cg[8], o[8];
#pragma unroll
                        for (int e = 0; e < 4; ++e) { cv[2 * e] = bflo(a[e]); cv[2 * e + 1] = bfhi(a[e]); cg[2 * e] = bflo(b[e]); cg[2 * e + 1] = bfhi(b[e]); }
#pragma unroll
                        for (int e = 0; e < 8; ++e) { const float va = bv[e] + wv[0][e] * p2v[e] + wv[1][e] * p1v[e] + wv[2][e] * cv[e]; const float ga = bg[e] + wg[0][e] * p2g[e] + wg[1][e] * p1g[e] + wg[2][e] * cg[e];
                            o[e] = gelu_tanh_f(ga) * va; p2v[e] = p1v[e]; p1v[e] = cv[e]; p2g[e] = p1g[e]; p1g[e] = cg[e]; }
                        u32x4 ov; ov.x = pk2(o[0], o[1]); ov.y = pk2(o[2], o[3]); ov.z = pk2(o[4], o[5]); ov.w = pk2(o[6], o[7]);
                        *(u32x4*)(ACT + (size_t)(lr0 + r) * D_FF + j0) = ov; }
                } }
        } else if ((k == 8 || k == 20) && PHM(8)) { asm volatile("; ==PHASE 8");
            const int layer = k == 8 ? 0 : 1;
            pg8::Gemm g{(const bf16_t*)(big + B_ACT), WT_down + (size_t)layer * 1024 * 2816, 16384, 1024, 2816, 2816, 2816, 0, 0, 0}; S.init(16384, 1024, G, bx);
            EpiBf16 E{(bf16_t*)(big + B_F), 1024, nullptr, nullptr, m0}; pg8::gemm_phase<EpiBf16>(lds, g, S, E, tid);
        } else if (k == 10 && PHM(10)) { asm volatile("; ==PHASE 10");
            { pg8::Gemm g{XN, WT_kv, Mh, 768, 1024, 1024, 1024, 0, 0, 0}; S.init(Mh, 768, G, bx); EpiF32 E{(float*)(big + B_KVRAW), 768}; pg8::gemm_phase<EpiF32>(lds, g, S, E, tid); }
        } else if (k == 11 && PHM(11)) { asm volatile("; ==PHASE 11");
            const float* KVRAW = (const float*)(big + B_KVRAW); const float* CQRAW = (const float*)(big + B_CQRAW); bf16_t* CQ = (bf16_t*)(big + B_CQ);
            LAS bf16_t* Tt = (LAS bf16_t*)lds;
            const int nchunk = Mh / 64;
            for (int ci = bx; ci < nchunk; ci += G) { int seq, t0, T; row_decode(m0 + ci * 64, seq, t0, T); const bool smp = seq >= 16;
                bf16_t* kcb; bf16_t* vtb; int Sk, key0;
                if (smp) { kcb = KCS + (size_t)(seq - 16) * 2112 * 320; vtb = VTS + (size_t)(seq - 16) * 256 * 2112; Sk = 2112; key0 = 2048 + t0; }
                else { const int sl = seq & 7; kcb = KC + (size_t)sl * 2048 * 320; vtb = VT + (size_t)sl * 256 * 2048; Sk = 2048; key0 = t0; }
                __syncthreads();
                for (int rr8 = 0; rr8 < 8; ++rr8) { const int li = wave * 8 + rr8, lr = ci * 64 + li, t = t0 + li; const int key = key0 + li;
                    const f32x4 v = *(const f32x4*)(KVRAW + (size_t)lr * 768 + lane * 4);
                    const float rr = __builtin_amdgcn_rsqf(wave_sum(v[0] * v[0] + v[1] * v[1] + v[2] * v[2] + v[3] * v[3]) * (1.f / 256.f) + EPS);
                    const f32x4 gg = *(const f32x4*)(pp->in[21] + lane * 4); const f32x4 cv = v * rr * gg;
                    float* lo = out + (smp ? O_SLAT + ((size_t)(seq - 16) * 64 + t) * 256 : O_PLAT + ((size_t)seq * 2048 + t) * 256);
                    *(f32x4*)(lo + lane * 4) = cv;
                    u32x2 o; o.x = pk2(cv[0], cv[1]); o.y = pk2(cv[2], cv[3]);
                    *(u32x2*)(kcb + (size_t)key * 320 + lane * 4) = o;
                    if (lane < 32) { const float x1 = KVRAW[(size_t)lr * 768 + 256 + lane], x2 = KVRAW[(size_t)lr * 768 + 288 + lane];
                        const float inv = __expf(-9.210340371976184f * (float)lane * (1.f / 32.f)); const float ang = (float)(smp ? 2048 + t : t) * inv; float sn, cs; sincos_rev(ang, sn, cs);
                        const float o1 = x1 * cs - x2 * sn, o2 = x2 * cs + x1 * sn;
                        float* ko = out + (smp ? O_SKPE + ((size_t)(seq - 16) * 64 + t) * 64 : O_PKPE + ((size_t)seq * 2048 + t) * 64);
                        ko[lane] = o1; ko[32 + lane] = o2;
                        kcb[(size_t)key * 320 + 256 + lane] = (bf16_t)f2bf(o1); kcb[(size_t)key * 320 + 288 + lane] = (bf16_t)f2bf(o2); } }
            }
            for (int lr = gw; lr < Mh; lr += NGW) { const f32x4 a = *(const f32x4*)(KVRAW + (size_t)lr * 768 + 320 + lane * 4); const f32x2 b = *(const f32x2*)(KVRAW + (size_t)lr * 768 + 576 + lane * 2);
                const float rr = __builtin_amdgcn_rsqf(wave_sum(a[0] * a[0] + a[1] * a[1] + a[2] * a[2] + a[3] * a[3] + b[0] * b[0] + b[1] * b[1]) * (1.f / 384.f) + EPS);
                const f32x4 ga = *(const f32x4*)(pp->in[26] + lane * 4); const f32x2 gb = *(const f32x2*)(pp->in[26] + 256 + lane * 2);
                u32x2 o; o.x = pk2(a[0] * rr * ga[0], a[1] * rr * ga[1]); o.y = pk2(a[2] * rr * ga[2], a[3] * rr * ga[3]);
                *(u32x2*)(CQ + (size_t)lr * 384 + lane * 4) = o; *(unsigned*)(CQ + (size_t)lr * 384 + 256 + lane * 2) = pk2(b[0] * rr * gb[0], b[1] * rr * gb[1]); }
        } else if (k == 12 && PHM(12)) { asm volatile("; ==PHASE 12");
            pg8::Gemm g{(const bf16_t*)(big + B_CQ), WT_uq, Mh, 3072, 384, 384, 384, 0, 0, 0}; S.init(Mh, 3072, G, bx);
            EpiUq E{(bf16_t*)(big + B_QNOPE), (bf16_t*)(big + B_QF)}; pg8::gemm_phase<EpiUq>(lds, g, S, E, tid);
        } else if (k == 13 && PHM(13)) { asm volatile("; ==PHASE 13");
            const float scale = 0.07216878364870322f * 1.4426950408889634f;
            { pg8::Gemm g{(const bf16_t*)(big + B_QNOPE), WUK, Mh, 4096, 128, 2048, 128, 128, 0, 0}; S.init(Mh, 4096, G, bx);
              EpiQlat E{(bf16_t*)(big + B_QF), scale}; pg8::gemm_phase<EpiQlat>(lds, g, S, E, tid); }
            bf16_t* QF = (bf16_t*)(big + B_QF);
            for (int lr = gw; lr < Mh; lr += NGW) { int seq, t, T; row_decode(m0 + lr, seq, t, T); const float pos = (float)(seq >= 16 ? 2048 + t : t);
                const int head = lane >> 2, i0 = (lane & 3) * 8; bf16_t* p = QF + (size_t)lr * 5120 + head * 320 + 256 + i0;
                const u32x4 a = *(const u32x4*)p, b = *(const u32x4*)(p + 32); float o1[8], o2[8];
#pragma unroll
                for (int e = 0; e < 8; ++e) { const float x1 = (e & 1) ? bfhi(a[e >> 1]) : bflo(a[e >> 1]), x2 = (e & 1) ? bfhi(b[e >> 1]) : bflo(b[e >> 1]);
                    const float inv = __expf(-9.210340371976184f * (float)(i0 + e) * (1.f / 32.f)); float sn, cs; sincos_rev(pos * inv, sn, cs);
                    o1[e] = (x1 * cs - x2 * sn) * scale; o2[e] = (x2 * cs + x1 * sn) * scale; }
                u32x4 w1, w2;
#pragma unroll
                for (int e = 0; e < 4; ++e) { w1[e] = pk2(o1[2 * e], o1[2 * e + 1]); w2[e] = pk2(o2[2 * e], o2[2 * e + 1]); }
                *(u32x4*)p = w1; *(u32x4*)(p + 32) = w2; }
        } else if (k == 14 && PHM(14)) { asm volatile("; ==PHASE 14");
            bf16_t* QF = (bf16_t*)(big + B_QF);
            typedef LAS bf16x4* trp_t; typedef float f32x16 __attribute__((ext_vector_type(16)));
            constexpr int KT = 41984, PB0 = 3 * KT, PSL = 4224, LSUM = PB0 + 8 * PSL;
            const bool swave = wave < 4; const int grp = wave & 3; const int c32 = lane & 31, h2 = lane >> 5;
            const int nsmp = pass ? 256 : 0, nunits = nsmp + 2048;
            const int wiq = G == 256 ? ((((bx >> 6) * 8 + (bx & 7)) << 3) | ((bx >> 3) & 7)) : bx;
#define ATT_STAGE(it_) do { if ((it_) + 1 < ntile) { LAS unsigned char* ktn = lds + (((it_) + 1) % 3) * KT; \
                _Pragma("unroll") for (int i = 0; i < 10; ++i) { *(LAS u32x4*)(ktn + sto + i * 16) = pk[i]; } \
                if ((it_) + 2 < ntile) { const int k0 = ((it_) + 2) * 64; \
                    _Pragma("unroll") for (int i = 0; i < 10; ++i) { pk[i] = *(const u32x4*)(kcb + (size_t)k0 * 320 + gto + i * 8); } } } } while (0)
            for (int un = wiq; un < nunits; un += G) {
                int row0, ntile; const bf16_t* kcb; int sub, hh;
                if (un < nsmp) { const int sb = un >> 3; sub = (un & 7) >> 1; hh = un & 1; row0 = NPROMPT_ROWS + sb * 64 + sub * 16; ntile = 33; kcb = KCS + (size_t)sb * 2112 * 320; }
                else { const int r0_ = un - nsmp; const int rnd = r0_ / G, wi = r0_ - rnd * G; const int r = ((rnd & 1) && (rnd + 1) * G <= 2048) ? rnd * G + (G - 1 - wi) : r0_;
                    const int qc = 31 - (r >> 6), rem = r & 63, sl = rem >> 3; sub = (rem & 7) >> 1; hh = rem & 1; const int seq = (pass ? 8 : 0) + sl;
                    row0 = seq * 2048 + qc * 64 + sub * 16; ntile = qc + 1; kcb = KC + (size_t)sl * 2048 * 320; }
                const int lrow0 = row0 - m0, head = hh * 8 + 2 * grp + (c32 >> 4);
                bf16_t* qrow = QF + (size_t)(lrow0 + (c32 & 15)) * 5120 + head * 320;
                __syncthreads();
                if (swave) { __builtin_amdgcn_s_setprio(2);
                    bf16x8 qf[20]; float mrun = -1e30f, lrun = 0.f;
                    u32x4 pk[10]; const int sto = ((tid >> 2) * 328 + (tid & 3) * 80) * 2, gto = (tid >> 2) * 320 + (tid & 3) * 80;
#pragma unroll
                    for (int i = 0; i < 10; ++i) { pk[i] = *(const u32x4*)(kcb + gto + i * 8); }
#pragma unroll
                    for (int ks = 0; ks < 20; ++ks) qf[ks] = *(const bf16x8*)(qrow + ks * 16 + h2 * 8);
#pragma unroll
                    for (int i = 0; i < 10; ++i) { *(LAS u32x4*)(lds + sto + i * 16) = pk[i]; }
                    { const int k1 = ntile > 1 ? 64 : 0;
#pragma unroll
                      for (int i = 0; i < 10; ++i) { pk[i] = *(const u32x4*)(kcb + (size_t)k1 * 320 + gto + i * 8); } }
                    __syncthreads();
                    for (int it = 0; it <= ntile; ++it) {
                        ATT_STAGE(it);
                        if (it < ntile) {
                            LAS unsigned char* kt = lds + (it % 3) * KT; LAS unsigned char* pb = lds + PB0 + ((it & 1) * 4 + grp) * PSL;
                            f32x16 sacc[2];
#pragma unroll
                            for (int kb = 0; kb < 2; ++kb)
#pragma unroll
                                for (int i = 0; i < 16; ++i) sacc[kb][i] = 0.f;
#pragma unroll
                            for (int ks = 0; ks < 20; ++ks) {
#pragma unroll
                                for (int kb = 0; kb < 2; ++kb) { const bf16x8 a = *(const LAS bf16x8*)(kt + ((kb * 32 + c32) * 328 + ks * 16 + h2 * 8) * 2); sacc[kb] = __builtin_amdgcn_mfma_f32_32x32x16_bf16(a, qf[ks], sacc[kb], 0, 0, 0); }
                            }
                            float mx = -1e30f;
#pragma unroll
                            for (int kb = 0; kb < 2; ++kb)
#pragma unroll
                                for (int i = 0; i < 16; ++i) mx = fmaxf(mx, sacc[kb][i]);
                            mx = fmaxf(mx, __shfl_xor(mx, 32));
                            const float mnew = fmaxf(mrun, mx), alpha = __builtin_amdgcn_exp2f(mrun - mnew); float rs = 0.f;
#pragma unroll
                            for (int kb = 0; kb < 2; ++kb)
#pragma unroll
                                for (int i = 0; i < 16; ++i) { sacc[kb][i] = __builtin_amdgcn_exp2f(sacc[kb][i] - mnew); rs += sacc[kb][i]; }
                            rs += __shfl_xor(rs, 32);
                            lrun = lrun * alpha + rs; mrun = mnew;
#pragma unroll
                            for (int kb = 0; kb < 2; ++kb)
#pragma unroll
                                for (int sp = 0; sp < 2; ++sp) { u32x4 pv; pv.x = pk2(sacc[kb][8 * sp + 0], sacc[kb][8 * sp + 1]); pv.y = pk2(sacc[kb][8 * sp + 2], sacc[kb][8 * sp + 3]); pv.z = pk2(sacc[kb][8 * sp + 4], sacc[kb][8 * sp + 5]); pv.w = pk2(sacc[kb][8 * sp + 6], sacc[kb][8 * sp + 7]);
                                    *(LAS u32x4*)(pb + (kb * 2 + sp) * 1024 + lane * 16) = pv; }
                            if (lane < 32) *(LAS float*)(pb + 4096 + lane * 4) = alpha;
                        }
                        __syncthreads();
                    }
                    if (lane < 32) *(LAS float*)(lds + LSUM + grp * 128 + lane * 4) = lrun;
                    __builtin_amdgcn_s_setprio(0);
                    __syncthreads();
                } else {
                    f32x16 oacc[8];
#pragma unroll
                    for (int rb = 0; rb < 8; ++rb)
#pragma unroll
                        for (int i = 0; i < 16; ++i) oacc[rb][i] = 0.f;
                    __syncthreads();
                    for (int it = 0; it <= ntile; ++it) {
                        if (it >= 1) {
                            LAS unsigned char* kt = lds + ((it - 1) % 3) * KT; LAS unsigned char* pb = lds + PB0 + (((it - 1) & 1) * 4 + grp) * PSL;
                            const float al = *(const LAS float*)(pb + 4096 + c32 * 4);
                            if (__any(al != 1.f)) {
#pragma unroll
                                for (int rb = 0; rb < 8; ++rb) oacc[rb] = oacc[rb] * al; }
                            LAS unsigned char* trb = kt + ((4 * h2 + ((lane & 15) >> 2)) * 328 + ((lane >> 4) & 1) * 16 + 4 * (lane & 3)) * 2;
#pragma unroll 2
                            for (int st = 0; st < 4; ++st) { const bf16x8 pv = *(const LAS bf16x8*)(pb + st * 1024 + lane * 16); LAS unsigned char* tr2 = trb + st * 16 * 656;
#pragma unroll
                                for (int rb = 0; rb < 8; ++rb) { const bf16x4 a0 = __builtin_amdgcn_ds_read_tr16_b64_v4i16((trp_t)(tr2 + rb * 64)), a1 = __builtin_amdgcn_ds_read_tr16_b64_v4i16((trp_t)(tr2 + 8 * 656 + rb * 64));
                                    const bf16x8 a = (bf16x8){a0[0], a0[1], a0[2], a0[3], a1[0], a1[1], a1[2], a1[3]};
                                    oacc[rb] = __builtin_amdgcn_mfma_f32_32x32x16_bf16(a, pv, oacc[rb], 0, 0, 0); } }
                        }
                        __syncthreads();
                    }
                    __syncthreads();
                    int ln2; asm volatile("v_mbcnt_lo_u32_b32 %0, -1, 0\n\tv_mbcnt_hi_u32_b32 %0, -1, %0" : "=v"(ln2));
                    const int c2 = ln2 & 31, hb = ln2 >> 5;
                    bf16_t* orow = QF + (size_t)(lrow0 + (c2 & 15)) * 5120 + (hh * 8 + 2 * grp + (c2 >> 4)) * 320;
                    const float inv = 1.f / *(const LAS float*)(lds + LSUM + grp * 128 + c2 * 4);
#pragma unroll
                    for (int rb = 0; rb < 8; ++rb)
#pragma unroll
                        for (int g4 = 0; g4 < 4; ++g4) { u32x2 o; o.x = pk2(oacc[rb][4 * g4 + 0] * inv, oacc[rb][4 * g4 + 1] * inv); o.y = pk2(oacc[rb][4 * g4 + 2] * inv, oacc[rb][4 * g4 + 3] * inv);
                            *(u32x2*)(orow + rb * 32 + 8 * g4 + 4 * hb) = o; }
                }
            }
#undef ATT_STAGE
        } else if (k == 15 && PHM(15)) { asm volatile("; ==PHASE 15");
            pg8::Gemm g{(const bf16_t*)(big + B_QF), WUV, Mh, 2048, 640, 5120, 640, 640, 0, 0}; S.init(Mh, 2048, G, bx);
            EpiBf16 E{(bf16_t*)(big + B_O2), 2048, nullptr, nullptr, m0}; pg8::gemm_phase<EpiBf16>(lds, g, S, E, tid);
        } else if (k == 16 && PHM(16)) { asm volatile("; ==PHASE 16");
            pg8::Gemm g{(const bf16_t*)(big + B_O2), WT_o, 16384, 1024, 2048, 2048, 2048, 0, 0, 0}; S.init(16384, 1024, G, bx);
            EpiBf16 E{(bf16_t*)(big + B_MIX1), 1024, nullptr, nullptr, m0}; pg8::gemm_phase<EpiBf16>(lds, g, S, E, tid);
        }
        if (pass && (k == 4 || k == 8 || k == 20 || k == 16)) {
            const bf16_t* A2; const bf16_t* B2; int ld2; float* part;
            if (k == 4) { A2 = (const bf16_t*)(big + B_Y); B2 = WT_out; ld2 = 2048; part = (float*)(big + B_PART0); }
            else if (k == 16) { A2 = (const bf16_t*)(big + B_O2); B2 = WT_o; ld2 = 2048; part = (float*)(big + B_PART2); }
            else { A2 = (const bf16_t*)(big + B_ACT); B2 = WT_down + (size_t)(k == 8 ? 0 : 1) * 1024 * 2816; ld2 = 2816; part = (float*)(big + B_PART1); }
            const int ns2 = (k == 4 || k == 16) ? 4 : 2, kp2 = ld2 / ns2;
            pg8::Gemm g{A2 + (size_t)16384 * ld2, B2, 2048, 1024 * ns2, kp2, ld2, ld2, 0, 4, kp2}; S.init(2048, 1024 * ns2, G, (bx + 96) % G);
            int lane2; asm volatile("v_mbcnt_lo_u32_b32 %0, -1, 0\n\tv_mbcnt_hi_u32_b32 %0, -1, %0" : "=v"(lane2));
            EpiF32Part E{part}; pg8::gemm_phase<EpiF32Part>(lds, g, S, E, wave_s * 64 + lane2);
        }
        if (ph + 1 < ph_hi) { XcdBarrier xb; xb.bar = (unsigned*)(ws + WS_CTL); xb.x = xb_xcc_id(); xb.st = (volatile LAS unsigned*)(lds + LDS_MISC); xcd_barrier(xb); }
    }
}

#ifndef MK_SINGLE
#define MK_SINGLE 1
#endif
extern "C" void kernel_launch(void* const* d_in, const int* in_sizes, int n_in, void* d_out, int out_size, void* d_ws, size_t ws_size, hipStream_t stream) {
    static int grid = 0;
    if (grid == 0) {
        if (n_in != 33 || ws_size < WS_CTL + CTL_BYTES) { fprintf(stderr, "kernel_launch: n_in %d ws %zu (need %zu)\n", n_in, ws_size, (size_t)WS_END); grid = -1; return; }
        int dev = 0, cus = 0, per_cu = 0;
        hipGetDevice(&dev); hipDeviceGetAttribute(&cus, hipDeviceAttributeMultiprocessorCount, dev);
        if (hipFuncSetAttribute((const void*)mk_fwd, hipFuncAttributeMaxDynamicSharedMemorySize, LDS_BYTES) != hipSuccess) { fprintf(stderr, "hipFuncSetAttribute failed\n"); grid = -1; return; }
        hipOccupancyMaxActiveBlocksPerMultiprocessor(&per_cu, (const void*)mk_fwd, 512, LDS_BYTES);
        if (per_cu < 1) { fprintf(stderr, "occupancy query says %d\n", per_cu); per_cu = 1; }
        (void)hipGetLastError();
        grid = cus * 1;
    }
    if (grid < 0) return;
    (void)hipMemsetAsync((char*)d_ws + WS_CTL, 0, CTL_BYTES, stream);
    Params p{};
    for (int i = 0; i < 33; ++i) p.in[i] = (const float*)d_in[i];
    p.out = (float*)d_out; p.ws = (unsigned char*)d_ws;
#if MK_SINGLE
    p.ph_lo = 0; p.ph_hi = 2 * (NPH + (DUP_PHASE >= 0 ? 1 : 0) + NULLPH);
    void* args[] = {&p};
    hipError_t e = hipLaunchCooperativeKernel((const void*)mk_fwd, dim3(grid), dim3(512), args, LDS_BYTES, stream);
    if (e != hipSuccess) fprintf(stderr, "cooperative launch failed: %s (grid %d)\n", hipGetErrorString(e), grid);
#else
    for (int ph = 0; ph < 2 * NPH; ++ph) { p.ph_lo = ph; p.ph_hi = ph + 1; hipLaunchKernelGGL(mk_fwd, dim3(grid), dim3(512), LDS_BYTES, stream, p); }
#endif
}
```
